# Optimizing an MI355X kernel written in HIP

```python
import math
import jax, jax.numpy as jnp
from jax import lax
import numpy as np

D_MODEL = 1024
BATCH = 8
SEQ = 2048
DEPTH = 4
DEC_BATCH = 128
DEC_SEQ = 8
PAST_LEN = 16384
PAGE_SIZE = 128

N_META = 16
N_MIXERS = 2
N_LAYERS_A = (DEPTH + 1) // 2
N_LAYERS_B = DEPTH // 2
S5_WIDTH = D_MODEL
S5_GROUP = 16
S5_GROUPS = S5_WIDTH // S5_GROUP
S5_STATE = 64
RG_WIDTH = D_MODEL
RG_BLOCKS = 4
RG_BLOCK = RG_WIDTH // RG_BLOCKS
RG_CONV = 4
RG_C = 8.0
FF_WIDTH = 2816
FF_CONV = 3
DN_ALPHA = (2 * DEPTH) ** 0.25
DN_BETA = (8 * DEPTH) ** -0.25
LN_EPS = 1e-5

kernel_name = "s5_rglru_convffn_deepnorm_meta_step"


def layer_norm(x, g, b):
    xf = x.astype(jnp.float32)
    mu = jnp.mean(xf, -1, keepdims=True)
    var = jnp.mean(jnp.square(xf - mu), -1, keepdims=True)
    y = (xf - mu) * lax.rsqrt(var + LN_EPS) * g.astype(jnp.float32) + b.astype(jnp.float32)
    return y.astype(x.dtype)


def causal_dwconv(x, hist, w, b):
    K = w.shape[0]
    L = x.shape[1]
    xp = jnp.concatenate([hist.astype(x.dtype), x], axis=1)
    y = b + w[0] * xp[:, 0:L]
    for k in range(1, K):
        y = y + w[k] * xp[:, k:k + L]
    return y, xp[:, L:]


def _complex_combine(e1, e2):
    a1r, a1i, b1r, b1i = e1
    a2r, a2i, b2r, b2i = e2
    return (a1r * a2r - a1i * a2i,
            a1r * a2i + a1i * a2r,
            a2r * b1r - a2i * b1i + b2r,
            a2r * b1i + a2i * b1r + b2i)


def _real_combine(e1, e2):
    a1, b1 = e1
    a2, b2 = e2
    return a1 * a2, a2 * b1 + b2


def s5_mixer(x, h_re, h_im, w_in, lam_re, lam_im, log_step, b_re, b_im, c_re, c_im, d_skip, w_out):
    f32 = jnp.float32
    Bsz, L, _ = x.shape
    u = x @ w_in
    ug = u.astype(f32).reshape(Bsz, L, S5_GROUPS, S5_GROUP)
    step = jnp.exp(log_step.astype(f32))[:, None]
    lr, li = lam_re.astype(f32), lam_im.astype(f32)
    mag = jnp.exp(lr * step)
    ab_re, ab_im = mag * jnp.cos(li * step), mag * jnp.sin(li * step)
    den = lr * lr + li * li
    nr, ni = ab_re - 1.0, ab_im
    q_re = ((nr * lr + ni * li) / den)[..., None]
    q_im = ((ni * lr - nr * li) / den)[..., None]
    br, bi = b_re.astype(f32), b_im.astype(f32)
    bb_re = q_re * br - q_im * bi
    bb_im = q_re * bi + q_im * br
    bu_re = jnp.einsum('blgh,gph->blgp', ug, bb_re)
    bu_im = jnp.einsum('blgh,gph->blgp', ug, bb_im)
    hr, hi = h_re.astype(f32), h_im.astype(f32)
    bu_re = bu_re.at[:, 0].add(ab_re * hr - ab_im * hi)
    bu_im = bu_im.at[:, 0].add(ab_re * hi + ab_im * hr)
    a_re = jnp.broadcast_to(ab_re, bu_re.shape)
    a_im = jnp.broadcast_to(ab_im, bu_im.shape)
    _, _, s_re, s_im = lax.associative_scan(_complex_combine, (a_re, a_im, bu_re, bu_im), axis=1)
    y = (jnp.einsum('blgp,ghp->blgh', s_re, c_re.astype(f32))
         - jnp.einsum('blgp,ghp->blgh', s_im, c_im.astype(f32)))
    y = y.reshape(Bsz, L, S5_WIDTH) + d_skip.astype(f32) * u.astype(f32)
    gy = jax.nn.gelu(y).astype(x.dtype)
    vg = gy @ w_out
    out = vg[..., :D_MODEL] * jax.nn.sigmoid(vg[..., D_MODEL:])
    return out, s_re[:, -1], s_im[:, -1]


def rglru_mixer(x, h0, conv_hist, w_in, conv_w, conv_b, w_gates, b_gates, lam, w_out):
    f32 = jnp.float32
    Bsz, L, _ = x.shape
    z = x @ w_in
    gate = jax.nn.gelu(z[..., :RG_WIDTH])
    xc, new_hist = causal_dwconv(z[..., RG_WIDTH:], conv_hist, conv_w, conv_b)
    xg = xc.reshape(Bsz, L, RG_BLOCKS, RG_BLOCK)
    gts = jnp.einsum('blnc,ncd->blnd', xg, w_gates)
    r = jax.nn.sigmoid((gts[..., :RG_BLOCK].reshape(Bsz, L, RG_WIDTH) + b_gates[:RG_WIDTH]).astype(f32))
    i = jax.nn.sigmoid((gts[..., RG_BLOCK:].reshape(Bsz, L, RG_WIDTH) + b_gates[RG_WIDTH:]).astype(f32))
    log_a = -RG_C * r * jax.nn.softplus(-lam.astype(f32))
    a = jnp.exp(log_a)
    mult = jnp.sqrt(-jnp.expm1(2.0 * log_a))
    b = mult * (i * xc.astype(f32))
    b = b.at[:, 0].add(a[:, 0] * h0.astype(f32))
    _, h = lax.associative_scan(_real_combine, (a, b), axis=1)
    y = (h.astype(x.dtype) * gate) @ w_out
    return y, h[:, -1], new_hist


def conv_ffn(x, hist, w_up, conv_w, conv_b, w_down):
    up = x @ w_up
    upc, new_hist = causal_dwconv(up, hist, conv_w, conv_b)
    y = (jax.nn.gelu(upc[..., FF_WIDTH:]) * upc[..., :FF_WIDTH]) @ w_down
    return y, new_hist


def _trunk(h, s5_re0, s5_im0, rg_h0, rg_conv0, ff_conv0, p):
    s5r, s5i, rgh, rgc, ffc = [], [], [], [], []
    for i in range(DEPTH):
        j = i // N_MIXERS
        if i % N_MIXERS == 0:
            mix, sr, si = s5_mixer(h, s5_re0[j], s5_im0[j], p['s5_w_in'][j], p['s5_lam_re'][j],
                                   p['s5_lam_im'][j], p['s5_log_step'][j], p['s5_b_re'][j],
                                   p['s5_b_im'][j], p['s5_c_re'][j], p['s5_c_im'][j],
                                   p['s5_d'][j], p['s5_w_out'][j])
            s5r.append(sr)
            s5i.append(si)
        else:
            mix, hr, cb = rglru_mixer(h, rg_h0[j], rg_conv0[j], p['rg_w_in'][j], p['rg_conv_w'][j],
                                      p['rg_conv_b'][j], p['rg_w_gates'][j], p['rg_b_gates'][j],
                                      p['rg_lam'][j], p['rg_w_out'][j])
            rgh.append(hr)
            rgc.append(cb)
        h = layer_norm(DN_ALPHA * h + mix, p['ln_g'][i, 0], p['ln_b'][i, 0])
        f, fb = conv_ffn(h, ff_conv0[i], p['ffn_w_up'][i], p['ffn_conv_w'][i], p['ffn_conv_b'][i],
                         p['ffn_w_down'][i])
        ffc.append(fb)
        h = layer_norm(DN_ALPHA * h + f, p['ln_g'][i, 1], p['ln_b'][i, 1])
    return h, jnp.stack(s5r), jnp.stack(s5i), jnp.stack(rgh), jnp.stack(rgc), jnp.stack(ffc)


def setup_inputs(seed: int = 0) -> dict:
    key = jax.random.key(seed)
    ks = list(jax.random.split(key, 40))
    nrm = lambda k, s, sc: jax.random.normal(k, s, jnp.float32) * sc
    E, G, P, H = S5_WIDTH, S5_GROUPS, S5_STATE, S5_GROUP
    R, F = RG_WIDTH, FF_WIDTH
    lam_im = jnp.pi * jnp.arange(P, dtype=jnp.float32)
    a_c = jax.random.uniform(ks[20], (N_LAYERS_B, R), jnp.float32, 0.9, 0.999)
    s = a_c ** (1.0 / RG_C)
    s5_w_out = jnp.concatenate([nrm(ks[18], (N_LAYERS_A, E, D_MODEL), E ** -0.5 * DN_BETA),
                                nrm(ks[19], (N_LAYERS_A, E, D_MODEL), E ** -0.5)], axis=-1)
    return {
        "x_prompt": nrm(ks[0], (BATCH, SEQ, D_MODEL), 1.0),
        "x_sample": nrm(ks[1], (DEC_BATCH, DEC_SEQ, D_MODEL), 1.0),
        "state_s5_re": nrm(ks[2], (N_LAYERS_A, DEC_BATCH, G, P), 0.1),
        "state_s5_im": nrm(ks[3], (N_LAYERS_A, DEC_BATCH, G, P), 0.1),
        "state_rg_h": nrm(ks[4], (N_LAYERS_B, DEC_BATCH, R), 0.5),
        "state_rg_conv": nrm(ks[5], (N_LAYERS_B, DEC_BATCH, RG_CONV - 1, R), 1.0),
        "state_ffn_conv": nrm(ks[6], (DEPTH, DEC_BATCH, FF_CONV - 1, 2 * F), 1.0),
        "meta_tokens": nrm(ks[7], (N_META, D_MODEL), 1.0),
        "s5_w_in": nrm(ks[8], (N_LAYERS_A, D_MODEL, E), D_MODEL ** -0.5),
        "s5_lam_re": -0.5 + nrm(ks[9], (N_LAYERS_A, G, P), 0.01),
        "s5_lam_im": lam_im + nrm(ks[10], (N_LAYERS_A, G, P), 0.01),
        "s5_log_step": jax.random.uniform(ks[11], (N_LAYERS_A, G), jnp.float32,
                                          math.log(0.001), math.log(0.1)),
        "s5_b_re": nrm(ks[12], (N_LAYERS_A, G, P, H), (2 * H) ** -0.5),
        "s5_b_im": nrm(ks[13], (N_LAYERS_A, G, P, H), (2 * H) ** -0.5),
        "s5_c_re": nrm(ks[14], (N_LAYERS_A, G, H, P), 0.5),
        "s5_c_im": nrm(ks[15], (N_LAYERS_A, G, H, P), 0.5),
        "s5_d": nrm(ks[16], (N_LAYERS_A, E), 1.0),
        "s5_w_out": s5_w_out,
        "rg_w_in": nrm(ks[21], (N_LAYERS_B, D_MODEL, 2 * R), D_MODEL ** -0.5),
        "rg_conv_w": nrm(ks[22], (N_LAYERS_B, RG_CONV, R), RG_CONV ** -0.5),
        "rg_conv_b": nrm(ks[23], (N_LAYERS_B, R), 0.01),
        "rg_w_gates": nrm(ks[24], (N_LAYERS_B, RG_BLOCKS, RG_BLOCK, 2 * RG_BLOCK), RG_BLOCK ** -0.5),
        "rg_b_gates": nrm(ks[25], (N_LAYERS_B, 2 * R), 0.01),
        "rg_lam": jnp.log(s) - jnp.log1p(-s),
        "rg_w_out": nrm(ks[26], (N_LAYERS_B, R, D_MODEL), R ** -0.5 * DN_BETA),
        "ffn_w_up": nrm(ks[27], (DEPTH, D_MODEL, 2 * F), D_MODEL ** -0.5),
        "ffn_conv_w": nrm(ks[28], (DEPTH, FF_CONV, 2 * F), FF_CONV ** -0.5),
        "ffn_conv_b": nrm(ks[29], (DEPTH, 2 * F), 0.01),
        "ffn_w_down": nrm(ks[30], (DEPTH, F, D_MODEL), F ** -0.5 * DN_BETA),
        "ln_g": 1.0 + nrm(ks[31], (DEPTH, 2, D_MODEL), 0.02),
        "ln_b": nrm(ks[32], (DEPTH, 2, D_MODEL), 0.02),
    }


def reference(x_prompt, x_sample, state_s5_re, state_s5_im, state_rg_h, state_rg_conv, state_ffn_conv,
              meta_tokens, s5_w_in, s5_lam_re, s5_lam_im, s5_log_step, s5_b_re, s5_b_im, s5_c_re,
              s5_c_im, s5_d, s5_w_out, rg_w_in, rg_conv_w, rg_conv_b, rg_w_gates, rg_b_gates, rg_lam,
              rg_w_out, ffn_w_up, ffn_conv_w, ffn_conv_b, ffn_w_down, ln_g, ln_b):
    p = dict(s5_w_in=s5_w_in, s5_lam_re=s5_lam_re, s5_lam_im=s5_lam_im, s5_log_step=s5_log_step,
             s5_b_re=s5_b_re, s5_b_im=s5_b_im, s5_c_re=s5_c_re, s5_c_im=s5_c_im, s5_d=s5_d,
             s5_w_out=s5_w_out, rg_w_in=rg_w_in, rg_conv_w=rg_conv_w, rg_conv_b=rg_conv_b,
             rg_w_gates=rg_w_gates, rg_b_gates=rg_b_gates, rg_lam=rg_lam, rg_w_out=rg_w_out,
             ffn_w_up=ffn_w_up, ffn_conv_w=ffn_conv_w, ffn_conv_b=ffn_conv_b, ffn_w_down=ffn_w_down,
             ln_g=ln_g, ln_b=ln_b)
    bp = x_prompt.shape[0]
    dt = x_prompt.dtype
    h_p = jnp.concatenate([jnp.broadcast_to(meta_tokens[None].astype(dt), (bp, N_META, D_MODEL)),
                           x_prompt], axis=1)
    z_s5 = jnp.zeros((N_LAYERS_A, bp, S5_GROUPS, S5_STATE), jnp.float32)
    z_rgh = jnp.zeros((N_LAYERS_B, bp, RG_WIDTH), jnp.float32)
    z_rgc = jnp.zeros((N_LAYERS_B, bp, RG_CONV - 1, RG_WIDTH), dt)
    z_ffc = jnp.zeros((DEPTH, bp, FF_CONV - 1, 2 * FF_WIDTH), dt)
    yp, s5r_p, s5i_p, rgh_p, rgc_p, ffc_p = _trunk(h_p, z_s5, z_s5, z_rgh, z_rgc, z_ffc, p)
    ys, s5r_s, s5i_s, rgh_s, rgc_s, ffc_s = _trunk(x_sample, state_s5_re, state_s5_im, state_rg_h,
                                                    state_rg_conv, state_ffn_conv, p)
    return (yp[:, N_META:], ys, s5r_p, s5i_p, rgh_p, rgc_p, ffc_p, s5r_s, s5i_s, rgh_s, rgc_s, ffc_s)
```

```cpp
#include <hip/hip_runtime.h>
#include <hip/hip_cooperative_groups.h>
#include <cstdio>
namespace cg = cooperative_groups;
#define DUP_SYNC 0
#define DUP_P0 0
#define DUP_S5 0
#define DUP_SCAN 0
#define DUP_UP 0
#define DUP_RG 0
#define DUP_LN 0
#define DUP_G1 0
#define GSYNC() do { xcd_barrier(xbar); if (DUP_SYNC) xcd_barrier(xbar); } while (0)

#define LAS __attribute__((address_space(3)))
typedef unsigned short bf16_t;
typedef short bf16x8 __attribute__((ext_vector_type(8)));
typedef float f32x4 __attribute__((ext_vector_type(4)));
typedef float f32x16 __attribute__((ext_vector_type(16)));
typedef unsigned u32x4 __attribute__((ext_vector_type(4)));
typedef unsigned u32x2 __attribute__((ext_vector_type(2)));
#define DI __device__ __forceinline__

constexpr int D = 1024, FF = 2816, FF2 = 5632;
constexpr int NSAMP = 1024;
constexpr int LP = 2064;
constexpr int MT = 17536;
constexpr int MA = 17792;
constexpr float ALPHA = 1.6817928305074290f;
constexpr float LN_EPS = 1e-5f;

constexpr size_t SZ_ROWS_BF = (size_t)MA * 1024 * 2;
constexpr size_t WS_W_S5IN = 0;
constexpr size_t WS_W_S5OUT = WS_W_S5IN + (size_t)2 * 1024 * 1024 * 2;
constexpr size_t WS_W_RGIN = WS_W_S5OUT + (size_t)2 * 2048 * 1024 * 2;
constexpr size_t WS_W_RGG = WS_W_RGIN + (size_t)2 * 2048 * 1024 * 2;
constexpr size_t WS_W_RGOUT = WS_W_RGG + (size_t)2 * 2048 * 256 * 2;
constexpr size_t WS_W_UP = WS_W_RGOUT + (size_t)2 * 1024 * 1024 * 2;
constexpr size_t WS_W_DN = WS_W_UP + (size_t)4 * 5632 * 1024 * 2;
constexpr size_t WS_H = WS_W_DN + (size_t)4 * 1024 * 2816 * 2;
constexpr size_t WS_Z = WS_H + SZ_ROWS_BF;
constexpr size_t WS_BIG = WS_Z + (size_t)MA * 1024 * 4;
constexpr size_t WS_U = WS_BIG, WS_GY = WS_BIG + SZ_ROWS_BF;
constexpr size_t WS_ACT = WS_BIG;
constexpr size_t WS_GATE = WS_BIG, WS_XC = WS_BIG + SZ_ROWS_BF, WS_AB = WS_BIG + 2 * SZ_ROWS_BF;
constexpr size_t WS_SMALL = WS_BIG + 2 * SZ_ROWS_BF + (size_t)MA * 1024 * 4;
constexpr size_t WS_S5AB = WS_SMALL;
constexpr size_t WS_S5BB = WS_S5AB + 65536;
constexpr size_t WS_S5CC = WS_S5BB + 524288;
constexpr size_t WS_RGSP = WS_S5CC + 524288;
constexpr size_t WS_RSUM = WS_RGSP + 8192;
constexpr size_t WS_BAR = WS_RSUM + (size_t)548 * 1024 * 8;
constexpr size_t WS_TMAP = WS_BAR + 16384;
constexpr size_t WS_END = WS_TMAP + 2048;
constexpr size_t WS_PART_FFN = WS_BIG + (size_t)MA * FF * 2;
constexpr size_t WS_PART_RG = WS_AB;
static_assert(WS_PART_FFN + (size_t)220 * 131072 <= WS_SMALL, "partials must fit behind ACT");

constexpr size_t O_YP = 0, O_YS = O_YP + 16777216, O_S5RP = O_YS + 1048576, O_S5IP = O_S5RP + 65536, O_RGHP = O_S5IP + 65536,
                 O_RGCP = O_RGHP + 16384, O_FFCP = O_RGCP + 49152, O_S5RS = O_FFCP + 360448, O_S5IS = O_S5RS + 1048576,
                 O_RGHS = O_S5IS + 1048576, O_RGCS = O_RGHS + 262144, O_FFCS = O_RGCS + 786432;

struct Params { const float* in[31]; float* out; unsigned char* ws; };
typedef const Params __attribute__((address_space(4))) KParams;
DI const KParams* kparams() { const KParams* kp = (const KParams*)__builtin_amdgcn_kernarg_segment_ptr(); asm volatile("" : "+s"(kp)); return kp; }
enum { I_XP = 0, I_XS, I_S5RE, I_S5IM, I_RGH, I_RGCONV, I_FFCONV, I_META, I_S5WIN, I_LAMRE, I_LAMIM, I_LOGSTEP, I_BRE, I_BIM, I_CRE, I_CIM, I_S5D,
       I_S5WOUT, I_RGWIN, I_RGCW, I_RGCB, I_RGWG, I_RGBG, I_RGLAM, I_RGWOUT, I_WUP, I_FCW, I_FCB, I_WDN, I_LNG, I_LNB };

DI int opaque_tid() { int t = threadIdx.x; asm volatile("" : "+v"(t)); return t; }
DI int opaque_bid() { int b = blockIdx.x; asm volatile("" : "+s"(b)); return b; }
DI unsigned cvt_pk_bf16(float lo, float hi) { unsigned r; asm volatile("v_cvt_pk_bf16_f32 %0, %1, %2" : "=v"(r) : "v"(lo), "v"(hi)); return r; }
DI float bf2f(bf16_t b) { return __uint_as_float(((unsigned)b) << 16); }
DI float sigmoid_f(float x) { return __builtin_amdgcn_rcpf(1.0f + __builtin_amdgcn_exp2f(-1.4426950408889634f * x)); }
DI float gelu_f(float x) {
    const float u = x * (1.0f + 0.044715f * x * x);
    return x * __builtin_amdgcn_rcpf(1.0f + __builtin_amdgcn_exp2f(-2.3022081989f * u));
}
DI f32x4 ld4(const float* p) { return *(const f32x4*)p; }
DI void st4(float* p, f32x4 v) { *(f32x4*)p = v; }
DI unsigned pk_half2(float lo, float hi) { const _Float16 a = (_Float16)lo, b = (_Float16)hi; return (unsigned)__builtin_bit_cast(unsigned short, a) | ((unsigned)__builtin_bit_cast(unsigned short, b) << 16); }
DI float half_lo(unsigned w) { return (float)__builtin_bit_cast(_Float16, (unsigned short)(w & 0xffffu)); }
DI float half_hi(unsigned w) { return (float)__builtin_bit_cast(_Float16, (unsigned short)(w >> 16)); }

namespace pg8 {
constexpr int BM = 256, BK = 64, HALF = 128, HTB = HALF * BK * 2, STAGE_BYTES = 8 * HTB, NXCD = 8, WGM = 8;
DI int lds_byte(int r, int c) { const int st = (r >> 4) * 2 + (c >> 5), rr = r & 15, cc = c & 31, ob = rr * 64 + cc * 2; return st * 1024 + (ob ^ (((ob >> 9) & 1) << 5)); }
DI void stage_rc(int b, int& R, int& C) { const int st = b / 1024, sb = b % 1024, swz = sb ^ (((sb >> 9) & 1) << 5); R = (st >> 1) * 16 + swz / 64; C = (st & 1) * 32 + (swz % 64) / 2; }
DI int perm32(int rho) { const int n = rho >> 4, i = rho & 15; return 8 * (i >> 2) + 4 * n + (i & 3); }
struct Unit { int pm, pn; };
struct Gemm { const bf16_t* A; const bf16_t* Bt; };
template <int LDA_, int LDB_, int K_, int NM_, int NN_, int RSTRIDE_, int ACOL_> struct GC { static constexpr int lda = LDA_, ldb = LDB_, K = K_, nM = NM_, nN = NN_, rstride = RSTRIDE_, acolmode = ACOL_; };
struct StaticOrder {
    int nM, nN, nwg, G, c;
    DI void init(int nM_, int nN_, int G_, int c_) { nM = nM_; nN = nN_; nwg = nM * nN; G = G_; c = c_; }
    DI void unit(int Lu, Unit& u) const {
        int wgid = Lu; { const int q = nwg / NXCD, r = nwg % NXCD, xcd = wgid % NXCD, off = wgid / NXCD; wgid = (xcd < r ? xcd * (q + 1) : r * (q + 1) + (xcd - r) * q) + off; }
        const int nig = WGM * nN, gid = wgid / nig, fm = gid * WGM, gsz = (nM - fm) < WGM ? (nM - fm) : WGM;
        u.pm = fm + ((wgid % nig) % gsz); u.pn = (wgid % nig) / gsz;
    }
    DI bool next_item(int i, int nfull, int nitems, int nsplit, Unit& u, int& piece, int& kpart) const {
        const long L = (long)i * G + c; if (L >= nitems) return false;
        int Lu = (int)L; piece = -1; kpart = 0;
        if (nfull == nwg) { unit(Lu, u); return true; }
        if (Lu >= nfull) { const int q = Lu - nfull; piece = q; kpart = q % nsplit; const int t = q / nsplit; u.pm = nfull / nN + t / nN; u.pn = t % nN; return true; }
        StaticOrder Sf; Sf.init(nfull / nN, nN, G, c); Sf.unit(Lu, u); return true;
    }
    DI bool next(int i, Unit& u) const {
        const long L = (long)i * G + c; if (L >= nwg) return false;
        int wgid = (int)L; { const int q = nwg / NXCD, r = nwg % NXCD, xcd = wgid % NXCD, off = wgid / NXCD; wgid = (xcd < r ? xcd * (q + 1) : r * (q + 1) + (xcd - r) * q) + off; }
        const int nig = WGM * nN, gid = wgid / nig, fm = gid * WGM, gsz = (nM - fm) < WGM ? (nM - fm) : WGM;
        u.pm = fm + ((wgid % nig) % gsz); u.pn = (wgid % nig) / gsz; return true;
    }
};
template <class C> DI int rowbase(int pm) { return C::rstride == 256 ? 256 * pm : (pm < 4 ? 256 * pm : 1024 + C::rstride * (pm - 4)); }

template <class Epi, bool ROWPERM, class C, int NSPLIT = 0>
DI void gemm_phase(LAS unsigned char* lds, const Gemm g, const Epi& E) {
    int tid_ = threadIdx.x; asm volatile("" : "+v"(tid_)); int bid_ = blockIdx.x; asm volatile("" : "+s"(bid_));
    const int tid = tid_, wid = __builtin_amdgcn_readfirstlane(tid >> 6), lane = tid & 63, wr = wid >> 2, wc = wid & 3, fr = lane & 15, fq = lane >> 4;
    constexpr int K = C::K, nt = K / BK;
    StaticOrder S; S.init(C::nM, C::nN, (int)gridDim.x, bid_);
    const bool split = NSPLIT > 0 && gridDim.x == 256;
    const int nfull = split ? (S.nwg / S.G) * S.G : S.nwg;
    const int nitems = nfull + (S.nwg - nfull) * (NSPLIT > 0 ? NSPLIT : 1);
    constexpr int NKP = NSPLIT > 0 ? nt / NSPLIT : nt;
    unsigned voffA[2], voffB[2];
#pragma unroll
    for (int i = 0; i < 2; ++i) { int R, Cc; stage_rc(tid * 16 + i * 8192, R, Cc); const int Rb = Epi::PERM ? ((R & ~31) + perm32(R & 31)) : R;
        const int Ra = ROWPERM ? (128 * (R >> 6) + 8 * (R & 15) + ((R >> 4) & 3)) : R;
        voffA[i] = (unsigned)(Ra * C::lda + Cc) * 2u; voffB[i] = (unsigned)(Rb * C::ldb + Cc) * 2u; }
    const size_t kstep = (size_t)(BK * 2);
    constexpr size_t hstepA = ROWPERM ? (size_t)4 * C::lda * 2 : (size_t)HALF * C::lda * 2;
    constexpr size_t hstepB = (size_t)HALF * C::ldb * 2;
    const unsigned ldsw = (unsigned)wid * 1024u;
    const int aoff = lds_byte(wr * 64 + fr, fq * 8), boff = lds_byte(wc * 32 + fr, fq * 8);
#define PG8_SA(b, h) (((b) * 2 + (h)) * HTB)
#define PG8_SB(b, h) ((4 + (b) * 2 + (h)) * HTB)
#define PG8_STAGE(bufoff, gbase, voff) do { _Pragma("unroll") for (int _i = 0; _i < 2; ++_i) \
        __builtin_amdgcn_global_load_lds((const unsigned*)((const char*)(gbase) + (voff)[_i]), (LAS unsigned*)(lds + (bufoff) + ldsw + _i * 8192), 16, 0, 0); } while (0)
#define PG8_LDA(dst, b, h) do { _Pragma("unroll") for (int m = 0; m < 4; ++m) _Pragma("unroll") for (int k = 0; k < 2; ++k) dst[m][k] = *(const LAS bf16x8*)(lds + PG8_SA(b, h) + aoff + m * 2048 + k * 1024); } while (0)
#define PG8_LDB(dst, b, h) do { _Pragma("unroll") for (int n = 0; n < 2; ++n) _Pragma("unroll") for (int k = 0; k < 2; ++k) dst[n][k] = *(const LAS bf16x8*)(lds + PG8_SB(b, h) + boff + n * 2048 + k * 1024); } while (0)
#define PG8_MMA(ai, bj, At, Bt) do { __builtin_amdgcn_s_setprio(1); _Pragma("unroll") for (int m = 0; m < 4; ++m) _Pragma("unroll") for (int n = 0; n < 2; ++n) _Pragma("unroll") for (int k = 0; k < 2; ++k) \
        acc[ai][bj][m][n] = __builtin_amdgcn_mfma_f32_16x16x32_bf16(Bt[n][k], At[m][k], acc[ai][bj][m][n], 0, 0, 0); __builtin_amdgcn_s_setprio(0); } while (0)
#define PG8_WAIT_V(n) asm volatile("s_waitcnt vmcnt(" #n ")" ::: "memory")
#define PG8_WAIT_L(n) asm volatile("s_waitcnt lgkmcnt(" #n ")" ::: "memory")
#define PG8_BAR __builtin_amdgcn_s_barrier()
#define PG8_SCHED __builtin_amdgcn_sched_barrier(0)
#define PG8_ABASE(u) ((const char*)g.A + ((size_t)rowbase<C>((u).pm) * C::lda + (C::acolmode ? 256 * ((u).pn >> 1) : 0)) * 2)
#define PG8_BBASE(u) ((const char*)g.Bt + (size_t)(u).pn * 256 * C::ldb * 2)
    Unit cur, nxt; int ui = 0; int curp = -1, curk = 0, nxtp = -1, nxtk = 0;
    if (!S.next_item(0, nfull, nitems, NSPLIT > 0 ? NSPLIT : 1, cur, curp, curk)) return;
    f32x4 acc[2][2][4][2];
#pragma unroll
    for (int a = 0; a < 2; ++a)
#pragma unroll
        for (int b = 0; b < 2; ++b)
#pragma unroll
            for (int m = 0; m < 4; ++m)
#pragma unroll
                for (int n = 0; n < 2; ++n) acc[a][b][m][n] = (f32x4){0.f, 0.f, 0.f, 0.f};
    bf16x8 At[4][2], B0[2][2], B1[2][2];
    const char* cA = PG8_ABASE(cur) + (size_t)(curp >= 0 ? curk * NKP : 0) * kstep; const char* cB = PG8_BBASE(cur) + (size_t)(curp >= 0 ? curk * NKP : 0) * kstep;
    PG8_STAGE(PG8_SB(0, 0), cB, voffB); PG8_STAGE(PG8_SA(0, 0), cA, voffA); PG8_STAGE(PG8_SB(0, 1), cB + hstepB, voffB); PG8_STAGE(PG8_SA(0, 1), cA + hstepA, voffA);
    if (wr == 1) PG8_BAR;
    PG8_WAIT_V(4); PG8_BAR;
    PG8_STAGE(PG8_SB(1, 0), cB + kstep, voffB); PG8_STAGE(PG8_SA(1, 0), cA + kstep, voffA); PG8_STAGE(PG8_SB(1, 1), cB + hstepB + kstep, voffB);
    PG8_WAIT_V(6); PG8_BAR;
    for (;;) {
        const bool has_next = S.next_item(ui + 1, nfull, nitems, NSPLIT > 0 ? NSPLIT : 1, nxt, nxtp, nxtk);
        const char* nA = has_next ? PG8_ABASE(nxt) + (size_t)(nxtp >= 0 ? nxtk * NKP : 0) * kstep : cA; const char* nB = has_next ? PG8_BBASE(nxt) + (size_t)(nxtp >= 0 ? nxtk * NKP : 0) * kstep : cB;
        const int nkt = (NSPLIT > 0 && curp >= 0) ? NKP : nt;
#pragma unroll 1
        for (int t = 0; t < nkt; t += 2) {
            const bool last = (t == nkt - 2);
            const char* a1 = cA + (size_t)(t + 1) * kstep;
            const char* a2 = last ? nA : cA + (size_t)(t + 2) * kstep; const char* b2 = last ? nB : cB + (size_t)(t + 2) * kstep;
            const char* a3 = a2 + kstep; const char* b3 = b2 + kstep;
            PG8_LDB(B0, 0, 0); PG8_SCHED; PG8_LDA(At, 0, 0); PG8_STAGE(PG8_SA(1, 1), a1 + hstepA, voffA);
            PG8_WAIT_L(8); PG8_BAR; PG8_WAIT_L(0); PG8_MMA(0, 0, At, B0); PG8_BAR; PG8_SCHED;
            PG8_LDB(B1, 0, 1); PG8_STAGE(PG8_SB(0, 0), b2, voffB);
            PG8_BAR; PG8_WAIT_L(0); PG8_MMA(0, 1, At, B1); PG8_BAR;
            PG8_LDA(At, 0, 1); PG8_STAGE(PG8_SA(0, 0), a2, voffA);
            PG8_BAR; PG8_WAIT_L(0); PG8_MMA(1, 0, At, B0); PG8_BAR; PG8_SCHED;
            PG8_STAGE(PG8_SB(0, 1), b2 + hstepB, voffB);
            PG8_WAIT_V(6); PG8_BAR; PG8_MMA(1, 1, At, B1); PG8_BAR;
            PG8_LDB(B0, 1, 0); PG8_SCHED; PG8_LDA(At, 1, 0); PG8_STAGE(PG8_SA(0, 1), a2 + hstepA, voffA);
            PG8_WAIT_L(8); PG8_BAR; PG8_WAIT_L(0); PG8_MMA(0, 0, At, B0); PG8_BAR; PG8_SCHED;
            PG8_LDB(B1, 1, 1); PG8_STAGE(PG8_SB(1, 0), b3, voffB);
            PG8_BAR; PG8_WAIT_L(0); PG8_MMA(0, 1, At, B1); PG8_BAR;
            PG8_LDA(At, 1, 1); PG8_STAGE(PG8_SA(1, 0), a3, voffA);
            PG8_BAR; PG8_WAIT_L(0); PG8_MMA(1, 0, At, B0); PG8_BAR; PG8_SCHED;
            PG8_STAGE(PG8_SB(1, 1), b3 + hstepB, voffB);
            PG8_WAIT_V(6); PG8_BAR; PG8_MMA(1, 1, At, B1); PG8_BAR;
        }
        if constexpr (NSPLIT > 0) { if (curp >= 0) E.store_piece(acc, curp, wr, wc, fr, fq); else E(acc, cur, rowbase<C>(cur.pm), wr, wc, fr, fq, lds + STAGE_BYTES); }
        else E(acc, cur, rowbase<C>(cur.pm), wr, wc, fr, fq, lds + STAGE_BYTES);
        if (!has_next) break;
#pragma unroll
        for (int a = 0; a < 2; ++a)
#pragma unroll
            for (int b = 0; b < 2; ++b)
#pragma unroll
                for (int m = 0; m < 4; ++m)
#pragma unroll
                    for (int n = 0; n < 2; ++n) acc[a][b][m][n] = (f32x4){0.f, 0.f, 0.f, 0.f};
        cur = nxt; curp = nxtp; curk = nxtk; cA = nA; cB = nB; ++ui;
    }
    PG8_WAIT_V(0);
    if (wr == 0) PG8_BAR;
    PG8_BAR;
#undef PG8_SA
#undef PG8_SB
#undef PG8_STAGE
#undef PG8_LDA
#undef PG8_LDB
#undef PG8_MMA
#undef PG8_WAIT_V
#undef PG8_WAIT_L
#undef PG8_BAR
#undef PG8_SCHED
#undef PG8_ABASE
#undef PG8_BBASE
}
}
using pg8::Unit;
typedef f32x4 AccT[2][2][4][2];

struct EpiStoreBf16 {
    static constexpr bool PERM = true;
    bf16_t* O; int ldc;
    DI void operator()(const AccT& acc, const Unit& u, int rb, int wr, int wc, int fr, int fq, LAS unsigned char*) const {
        const int row0 = rb + wr * 64 + fr, col0 = u.pn * 256 + wc * 32 + 8 * fq;
#pragma unroll
        for (int ai = 0; ai < 2; ++ai)
#pragma unroll
            for (int m = 0; m < 4; ++m) { bf16_t* rowp = O + (size_t)(row0 + ai * 128 + m * 16) * ldc + col0;
#pragma unroll
                for (int bj = 0; bj < 2; ++bj) { const f32x4 v0 = acc[ai][bj][m][0], v1 = acc[ai][bj][m][1];
                    u32x4 w; w.x = cvt_pk_bf16(v0[0], v0[1]); w.y = cvt_pk_bf16(v0[2], v0[3]); w.z = cvt_pk_bf16(v1[0], v1[1]); w.w = cvt_pk_bf16(v1[2], v1[3]);
                    *(u32x4*)(rowp + bj * 128) = w; } }
    }
};
struct EpiAddZ {
    static constexpr bool PERM = false;
    unsigned short* Z; bf16_t* PART; const bf16_t* H;
    DI void store_piece(const AccT& acc, int piece, int wr, int wc, int fr, int fq) const {
        bf16_t* base = PART + (size_t)piece * 65536 + (size_t)(wr * 64 + fr) * 256 + wc * 32 + 4 * fq;
#pragma unroll
        for (int ai = 0; ai < 2; ++ai)
#pragma unroll
            for (int m = 0; m < 4; ++m)
#pragma unroll
                for (int bj = 0; bj < 2; ++bj)
#pragma unroll
                    for (int n = 0; n < 2; ++n) { const f32x4 v = acc[ai][bj][m][n]; u32x2 o; o.x = cvt_pk_bf16(v[0], v[1]); o.y = cvt_pk_bf16(v[2], v[3]);
                        *(u32x2*)(base + (size_t)(ai * 128 + m * 16) * 256 + bj * 128 + n * 16) = o; }
    }
    DI void operator()(const AccT& acc, const Unit& u, int rb, int wr, int wc, int fr, int fq, LAS unsigned char*) const {
        const int row0 = rb + wr * 64 + fr, col0 = u.pn * 256 + wc * 32 + 4 * fq;
#pragma unroll
        for (int ai = 0; ai < 2; ++ai) {
            u32x2 hw[4][2][2];
#pragma unroll
            for (int m = 0; m < 4; ++m) { const bf16_t* rowp = H + (size_t)(row0 + ai * 128 + m * 16) * D + col0;
#pragma unroll
                for (int bj = 0; bj < 2; ++bj)
#pragma unroll
                    for (int n = 0; n < 2; ++n) hw[m][bj][n] = *(const u32x2*)(rowp + bj * 128 + n * 16); }
#pragma unroll
            for (int m = 0; m < 4; ++m) { unsigned short* rowp = Z + (size_t)(row0 + ai * 128 + m * 16) * D + col0;
#pragma unroll
                for (int bj = 0; bj < 2; ++bj)
#pragma unroll
                    for (int n = 0; n < 2; ++n) { const u32x2 w = hw[m][bj][n];
                        const f32x4 hv = (f32x4){__uint_as_float(w.x << 16), __uint_as_float(w.x & 0xffff0000u), __uint_as_float(w.y << 16), __uint_as_float(w.y & 0xffff0000u)};
                        const f32x4 zz = hv * ALPHA + acc[ai][bj][m][n]; u32x2 o; o.x = pk_half2(zz[0], zz[1]); o.y = pk_half2(zz[2], zz[3]);
                        *(u32x2*)(rowp + bj * 128 + n * 16) = o; } }
            asm volatile("" ::: "memory");
        }
    }
};
struct EpiGluRes {
    static constexpr bool PERM = false;
    unsigned short* Z; const bf16_t* H; bf16_t* PART;
    DI void store_piece(const AccT& acc, int piece, int wr, int wc, int fr, int fq) const {
        bf16_t* base = PART + (size_t)piece * 65536 + (size_t)(wr * 64 + fr) * 256 + wc * 32 + 4 * fq;
#pragma unroll
        for (int ai = 0; ai < 2; ++ai)
#pragma unroll
            for (int m = 0; m < 4; ++m)
#pragma unroll
                for (int bj = 0; bj < 2; ++bj)
#pragma unroll
                    for (int n = 0; n < 2; ++n) { const f32x4 v = acc[ai][bj][m][n]; u32x2 o; o.x = cvt_pk_bf16(v[0], v[1]); o.y = cvt_pk_bf16(v[2], v[3]);
                        *(u32x2*)(base + (size_t)(ai * 128 + m * 16) * 256 + bj * 128 + n * 16) = o; }
    }
    DI void operator()(const AccT& acc, const Unit& u, int rb, int wr, int wc, int fr, int fq, LAS unsigned char*) const {
        const int row0 = rb + wr * 64 + fr, col0 = u.pn * 128 + wc * 32 + 4 * fq;
#pragma unroll
        for (int ai = 0; ai < 2; ++ai) {
            u32x2 hw[4][2];
#pragma unroll
            for (int m = 0; m < 4; ++m) { const bf16_t* rowp = H + (size_t)(row0 + ai * 128 + m * 16) * D + col0;
#pragma unroll
                for (int n = 0; n < 2; ++n) hw[m][n] = *(const u32x2*)(rowp + n * 16); }
#pragma unroll
            for (int m = 0; m < 4; ++m) { unsigned short* rowp = Z + (size_t)(row0 + ai * 128 + m * 16) * D + col0;
#pragma unroll
                for (int n = 0; n < 2; ++n) { const f32x4 v = acc[ai][0][m][n], gt = acc[ai][1][m][n]; const u32x2 w = hw[m][n];
                    f32x4 zz = (f32x4){__uint_as_float(w.x << 16), __uint_as_float(w.x & 0xffff0000u), __uint_as_float(w.y << 16), __uint_as_float(w.y & 0xffff0000u)} * ALPHA;
#pragma unroll
                    for (int e = 0; e < 4; ++e) zz[e] += v[e] * sigmoid_f(gt[e]);
                    { u32x2 o; o.x = pk_half2(zz[0], zz[1]); o.y = pk_half2(zz[2], zz[3]); *(u32x2*)(rowp + n * 16) = o; } } }
            asm volatile("" ::: "memory");
        }
    }
};
struct EpiRgGates {
    static constexpr bool PERM = false;
    const bf16_t* XC; unsigned* AB; const float* bgate; const float* sp; const float* h0;
    DI void operator()(const AccT& acc, const Unit& u, int rb, int wr, int wc, int fr, int fq, LAS unsigned char*) const {
        const int row0 = rb + wr * 64 + fr;
        bool special = (rb < NSAMP) || (rb + 256 > MT);
        if (!special) { const int q0 = rb - NSAMP; const int b0 = (q0 + LP - 1) / LP; special = (b0 * LP < q0 + 256); }
#define RGG_ELEM(T0) \
                            const float r = __builtin_amdgcn_rcpf(1.0f + __builtin_amdgcn_exp2f(fmaf(ar[e], -1.4426950408889634f, brs[e]))); \
                            const float ig = __builtin_amdgcn_rcpf(1.0f + __builtin_amdgcn_exp2f(fmaf(aiv[e], -1.4426950408889634f, bis[e]))); \
                            float la2 = r * spl[e];                                     \
                            const float a = __builtin_amdgcn_exp2f(la2); \
                            const float mult = __builtin_amdgcn_sqrtf(fmaf(-a, a, 1.0f));     \
                            float bb = mult * (ig * xc[e]); \
                            if (T0) { bb += a * hz[e]; la2 = -__builtin_inff(); } \
                            o[e] = pk_half2(la2, bb);
#pragma unroll
        for (int n = 0; n < 2; ++n) {
            const int ch = u.pn * 128 + wc * 32 + 16 * n + 4 * fq;
            const f32x4 brs = ld4(bgate + ch) * -1.4426950408889634f, bis = ld4(bgate + D + ch) * -1.4426950408889634f, spl = ld4(sp + ch) * (-8.0f * 1.4426950408889634f);
            if (!special) {
                u32x2 xw[8];
#pragma unroll
                for (int k = 0; k < 8; ++k) xw[k] = *(const u32x2*)(XC + (size_t)(row0 + (k >> 2) * 128 + (k & 3) * 16) * D + ch);
#pragma unroll
                for (int k = 0; k < 8; ++k) {
                    const int ai = k >> 2, m = k & 3;
                    const float xc[4] = {__uint_as_float(xw[k].x << 16), __uint_as_float(xw[k].x & 0xffff0000u), __uint_as_float(xw[k].y << 16), __uint_as_float(xw[k].y & 0xffff0000u)};
                    const f32x4 ar = acc[ai][0][m][n], aiv = acc[ai][1][m][n]; const f32x4 hz = (f32x4){0.f, 0.f, 0.f, 0.f};
                    u32x4 o;
#pragma unroll
                    for (int e = 0; e < 4; ++e) { RGG_ELEM(false) }
                    *(u32x4*)(AB + (size_t)(row0 + ai * 128 + m * 16) * D + ch) = o;
                }
                asm volatile("" ::: "memory");
            } else {
#pragma unroll
                for (int ai = 0; ai < 2; ++ai)
#pragma unroll
                    for (int m = 0; m < 4; ++m) {
                        const int row = row0 + ai * 128 + m * 16;
                        if (row < MT) {
                            int t, b; bool pr;
                            if (row < NSAMP) { pr = false; b = row >> 3; t = row & 7; } else { pr = true; const int q = row - NSAMP; b = q / LP; t = q - b * LP; }
                            const u32x2 xw = *(const u32x2*)(XC + (size_t)row * D + ch);
                            const float xc[4] = {__uint_as_float(xw.x << 16), __uint_as_float(xw.x & 0xffff0000u), __uint_as_float(xw.y << 16), __uint_as_float(xw.y & 0xffff0000u)};
                            f32x4 hz = (f32x4){0.f, 0.f, 0.f, 0.f};
                            if (t == 0 && !pr) hz = ld4(h0 + (size_t)b * D + ch);
                            const f32x4 ar = acc[ai][0][m][n], aiv = acc[ai][1][m][n];
                            u32x4 o;
#pragma unroll
                            for (int e = 0; e < 4; ++e) { RGG_ELEM(t == 0) }
                            *(u32x4*)(AB + (size_t)row * D + ch) = o;
                        }
                        asm volatile("" ::: "memory");
                    }
            }
        }
#undef RGG_ELEM
    }
};

template <int KW>
DI void conv_prev(const AccT& acc, int bj, int n, bool samp, int wr, int wc, int fr, int fq, const LAS float* xch, const float* histp  , int histld, f32x4 (&xm)[KW - 1]) {
    if (samp) {
#pragma unroll
        for (int k = 1; k < KW; ++k) xm[k - 1] = ld4(histp + (size_t)(KW - 1 - k) * histld);
    } else {
#pragma unroll
        for (int k = 1; k < KW; ++k) { const int j = 8 - k; const f32x4 a = acc[j >> 2][bj][j & 3][n]; f32x4 v;
#pragma unroll
            for (int e = 0; e < 4; ++e) v[e] = __shfl_up(a[e], 1, 16);
            if (fr == 0) { if (wr == 1) v = *(const LAS f32x4*)(xch + (k - 1) * 256 + 128 * bj + 32 * wc + 16 * n + 4 * fq); else v = (f32x4){0.f, 0.f, 0.f, 0.f}; }
            xm[k - 1] = v; }
    }
}
template <int KW>
DI void xch_write(const AccT& acc, LAS float* xch, int wr, int wc, int fr, int fq) {
    if (wr == 0 && fr == 15) {
#pragma unroll
        for (int k = 1; k < KW; ++k) { const int j = 8 - k;
#pragma unroll
            for (int bj = 0; bj < 2; ++bj)
#pragma unroll
                for (int n = 0; n < 2; ++n) *(LAS f32x4*)(xch + (k - 1) * 256 + 128 * bj + 32 * wc + 16 * n + 4 * fq) = acc[j >> 2][bj][j & 3][n]; }
    }
    asm volatile("s_waitcnt lgkmcnt(0)" ::: "memory");
}
#define XROW(bj, n, i) acc[(i) >> 2][bj][(i) & 3][n]

struct EpiFfnUp {
    static constexpr bool PERM = true;
    int layer;
    DI void operator()(const AccT& acc, const Unit& u, int rb, int wr, int wc, int fr_, int fq_, LAS unsigned char* ldsx) const {
        asm volatile("" ::: "memory");
        int fr = fr_, fq = fq_; asm volatile("" : "+v"(fr), "+v"(fq));
        const KParams* kp = kparams();
        int ly = layer; asm volatile("" : "+s"(ly));
        bf16_t* ACT = (bf16_t*)(kp->ws + WS_ACT);
        const float* cw = kp->in[I_FCW] + (size_t)ly * 3 * FF2; const float* cb = kp->in[I_FCB] + (size_t)ly * FF2; const float* hist = kp->in[I_FFCONV] + (size_t)ly * 128 * 2 * FF2;
        float* out = kp->out;
        LAS float* xch = (LAS float*)ldsx;
        LAS unsigned char* wslice = ldsx + 4096 + (wr * 4 + wc) * 1024;
        {
            const int L_ = fq * 16 + fr, arr = L_ & 3, fq2 = (L_ >> 2) & 3, n2 = (L_ >> 4) & 1, bj2 = L_ >> 5;
            const int col = 128 * u.pn + 32 * wc + 8 * fq2 + 4 * n2 + bj2 * FF;
            const float* srcp = (arr < 3) ? (cw + (size_t)arr * FF2 + col) : (cb + col);
            *(LAS f32x4*)(wslice + L_ * 16) = ld4(srcp);
        }
        const bool samp = u.pm < 4;
        const int g0 = rb + 128 * wr + 8 * fr;
        if (!samp) xch_write<3>(acc, xch, wr, wc, fr, fq);
        int t0, bsq;
        if (samp) { bsq = g0 >> 3; t0 = 0; } else { const int q = g0 - NSAMP; bsq = q / LP; t0 = q - bsq * LP; }
        const int jmin = (u.pm > 4 && wr == 0 && fr == 0) ? 2 : 0;
        const int L = samp ? 8 : LP;
        const int offsel = samp ? ((int)O_FFCS + ly * 128 * 2 * FF2) : ((int)O_FFCP + ly * 8 * 2 * FF2);
        asm volatile("s_waitcnt vmcnt(0) lgkmcnt(0)" ::: "memory");
        const bool anym = __any((!samp) && (t0 < 2 || t0 + 7 >= LP));
        u32x2 ob[8];
#pragma unroll
        for (int n = 0; n < 2; ++n) {
            const int cv = 128 * u.pn + 32 * wc + 8 * fq + 4 * n;
            f32x4 vm[2], gm[2];
            const float* hp = hist + (size_t)bsq * 2 * FF2 + cv;
            conv_prev<3>(acc, 0, n, samp, wr, wc, fr, fq, xch, hp, FF2, vm);
            conv_prev<3>(acc, 1, n, samp, wr, wc, fr, fq, xch, hp + FF, FF2, gm);
            const LAS f32x4* wsl = (const LAS f32x4*)wslice + (n * 4 + fq) * 4;
            const f32x4 wv0 = wsl[0], wv1 = wsl[1], wv2 = wsl[2], bv = wsl[3];
            const f32x4 wg0 = wsl[32], wg1 = wsl[33], wg2 = wsl[34], bg = wsl[35];
#define FFN_ROWS(MASK) _Pragma("unroll") \
            for (int j = 0; j < 8; ++j) { \
                int tj = t0 + j, bq = bsq; if (!samp && tj >= LP) { tj -= LP; bq++; } \
                const f32x4 z4 = (f32x4){0.f, 0.f, 0.f, 0.f}; \
                const f32x4 v0 = XROW(0, n, j), g0v = XROW(1, n, j); \
                f32x4 v1 = (j >= 1) ? XROW(0, n, (j >= 1 ? j - 1 : 0)) : vm[0], g1 = (j >= 1) ? XROW(1, n, (j >= 1 ? j - 1 : 0)) : gm[0]; \
                f32x4 v2 = (j >= 2) ? XROW(0, n, (j >= 2 ? j - 2 : 0)) : vm[j >= 2 ? 0 : 1 - j], g2 = (j >= 2) ? XROW(1, n, (j >= 2 ? j - 2 : 0)) : gm[j >= 2 ? 0 : 1 - j]; \
                if (MASK) { if (tj < 1) { v1 = z4; g1 = z4; } if (tj < 2) { v2 = z4; g2 = z4; } } \
                const f32x4 V = bv + wv2 * v0 + wv1 * v1 + wv0 * v2; \
                const f32x4 G = bg + wg2 * g0v + wg1 * g1 + wg0 * g2; \
                if (j >= jmin) { \
                    const int grow = g0 + j; \
                    const f32x4 A = G * (G * G * (-2.3022081989f * 0.044715f) + (-2.3022081989f)); \
                    f32x4 E; E[0] = __builtin_amdgcn_exp2f(A[0]); E[1] = __builtin_amdgcn_exp2f(A[1]); E[2] = __builtin_amdgcn_exp2f(A[2]); E[3] = __builtin_amdgcn_exp2f(A[3]); \
                    const f32x4 Dn = E + 1.0f; \
                    f32x4 R; R[0] = __builtin_amdgcn_rcpf(Dn[0]); R[1] = __builtin_amdgcn_rcpf(Dn[1]); R[2] = __builtin_amdgcn_rcpf(Dn[2]); R[3] = __builtin_amdgcn_rcpf(Dn[3]); \
                    const f32x4 O = (G * V) * R; \
                    u32x2 o; o.x = cvt_pk_bf16(O[0], O[1]); o.y = cvt_pk_bf16(O[2], O[3]); \
                    if (n == 0) ob[j] = o; else { u32x4 w4; w4.x = ob[j].x; w4.y = ob[j].y; w4.z = o.x; w4.w = o.y; *(u32x4*)(ACT + (size_t)grow * FF + (cv - 4)) = w4; } \
                    if (tj >= L - 2) { float* op = out + (size_t)(offsel + (bq * 2 + (tj - (L - 2))) * FF2 + cv); st4(op, v0); st4(op + FF, g0v); } \
                } \
                asm volatile("" ::: "memory"); \
            }
            if (anym) { FFN_ROWS(true) } else { FFN_ROWS(false) }
#undef FFN_ROWS
        }
    }
};
struct EpiRgIn {
    static constexpr bool PERM = false;
    int layer;
    DI void operator()(const AccT& acc, const Unit& u, int rb, int wr, int wc, int fr_, int fq_, LAS unsigned char* ldsx) const {
        asm volatile("" ::: "memory");
        int fr = fr_, fq = fq_; asm volatile("" : "+v"(fr), "+v"(fq));
        const KParams* kp = kparams();
        int ly = layer; asm volatile("" : "+s"(ly));
        bf16_t* GATE = (bf16_t*)(kp->ws + WS_GATE); bf16_t* XC = (bf16_t*)(kp->ws + WS_XC);
        const float* cw = kp->in[I_RGCW] + (size_t)ly * 4 * D; const float* cb = kp->in[I_RGCB] + (size_t)ly * D; const float* hist = kp->in[I_RGCONV] + (size_t)ly * 128 * 3 * D;
        float* out = kp->out; const int offP = (int)O_RGCP + ly * 8 * 3 * D, offS = (int)O_RGCS + ly * 128 * 3 * D;
        LAS float* xch = (LAS float*)ldsx;
        const bool samp = u.pm < 4;
        const int g0 = rb + 128 * wr + 8 * fr;
        const int jmin = (u.pm > 4 && wr == 0 && fr == 0) ? 3 : 0;
        if (u.pn < 4) {
#pragma unroll
            for (int bj = 0; bj < 2; ++bj)
#pragma unroll
                for (int n = 0; n < 2; ++n) { const int c = 256 * u.pn + 128 * bj + 32 * wc + 16 * n + 4 * fq;
#pragma unroll
                    for (int j = 0; j < 8; ++j) { const int grow = g0 + j;
                        if (j >= jmin && grow < MT) { const f32x4 v = XROW(bj, n, j); u32x2 o; o.x = cvt_pk_bf16(gelu_f(v[0]), gelu_f(v[1])); o.y = cvt_pk_bf16(gelu_f(v[2]), gelu_f(v[3]));
                            *(u32x2*)(GATE + (size_t)grow * D + c) = o; }
                        asm volatile("" ::: "memory"); } }
            return;
        }
        LAS unsigned char* wslice = ldsx + 4096 + (wr * 4 + wc) * 1280;
        {
            const int lane_ = fq * 16 + fr;
#pragma unroll
            for (int rep2 = 0; rep2 < 2; ++rep2) { const int sl = lane_ + 64 * rep2;
                if (sl < 80) { const int arr = sl % 5, tq = sl / 5, fq2 = tq & 3, n2 = (tq >> 2) & 1, bj2 = tq >> 3;
                    const int chs = 256 * (u.pn - 4) + 128 * bj2 + 32 * wc + 16 * n2 + 4 * fq2;
                    const float* srcp = (arr < 4) ? (cw + (size_t)arr * D + chs) : (cb + chs);
                    *(LAS f32x4*)(wslice + sl * 16) = ld4(srcp); } }
        }
        if (!samp) xch_write<4>(acc, xch, wr, wc, fr, fq);
        int t0, bsq;
        if (samp) { bsq = g0 >> 3; t0 = 0; } else { const int q = g0 - NSAMP; bsq = q / LP; t0 = q - bsq * LP; }
        const int L = samp ? 8 : LP;
        const int smask = -(int)samp; const int offsel = (offS & smask) | (offP & ~smask);
        asm volatile("s_waitcnt vmcnt(0) lgkmcnt(0)" ::: "memory");
        const bool anym = __any((!samp) && (t0 < 3 || t0 + 7 >= LP));
#pragma unroll
        for (int bj = 0; bj < 2; ++bj)
#pragma unroll
            for (int n = 0; n < 2; ++n) {
                const int ch = 256 * (u.pn - 4) + 128 * bj + 32 * wc + 16 * n + 4 * fq;
                f32x4 xm[3];
                conv_prev<4>(acc, bj, n, samp, wr, wc, fr, fq, xch, hist + (size_t)bsq * 3 * D + ch, D, xm);
                const LAS f32x4* wsl = (const LAS f32x4*)wslice + ((bj * 2 + n) * 4 + fq) * 5;
                const f32x4 w0 = wsl[0], w1 = wsl[1], w2 = wsl[2], w3 = wsl[3], bv = wsl[4];
#define RGIN_ROWS(MASK) _Pragma("unroll") \
                for (int j = 0; j < 8; ++j) { \
                    int tj = t0 + j, bq = bsq; if (!samp && tj >= LP) { tj -= LP; bq++; } \
                    const f32x4 z4 = (f32x4){0.f, 0.f, 0.f, 0.f}; \
                    const f32x4 x0 = XROW(bj, n, j); \
                    f32x4 x1 = (j >= 1) ? XROW(bj, n, (j >= 1 ? j - 1 : 0)) : xm[0]; \
                    f32x4 x2 = (j >= 2) ? XROW(bj, n, (j >= 2 ? j - 2 : 0)) : xm[j >= 2 ? 0 : 1 - j]; \
                    f32x4 x3 = (j >= 3) ? XROW(bj, n, (j >= 3 ? j - 3 : 0)) : xm[j >= 3 ? 0 : 2 - j]; \
                    if (MASK) { if (tj < 1) x1 = z4; if (tj < 2) x2 = z4; if (tj < 3) x3 = z4; } \
                    const f32x4 y = bv + w3 * x0 + w2 * x1 + w1 * x2 + w0 * x3; \
                    const int grow = g0 + j; \
                    if (j >= jmin && grow < MT) { \
                        u32x2 o; o.x = cvt_pk_bf16(y[0], y[1]); o.y = cvt_pk_bf16(y[2], y[3]); \
                        *(u32x2*)(XC + (size_t)grow * D + ch) = o; \
                        if (tj >= L - 3) st4(out + (size_t)(offsel + (bq * 3 + (tj - (L - 3))) * D + ch), x0); \
                    } \
                    asm volatile("" ::: "memory"); \
                }
                if (anym) { RGIN_ROWS(true) } else { RGIN_ROWS(false) }
#undef RGIN_ROWS
            }
    }
};

struct CvtJob { const float* src; bf16_t* dst; int K, Nsrc, Nt, Hn; };
DI void cvt_tile(const CvtJob& jb, int tile, LAS float* tl) {
    const int tid = opaque_tid();
    const int nkt = jb.K / 64; const int rt = tile / nkt, kt = tile - rt * nkt;
    const int r0 = rt * 256, k0 = kt * 64;
    int scA = r0, scB = r0 + 128;
    if (jb.Hn) { const int pn = r0 >> 8; scA = 128 * pn; scB = jb.Hn + 128 * pn; }
    { const int ty = tid >> 6, tx = tid & 63; float v[8][4];
#pragma unroll
      for (int i = 0; i < 8; ++i) { const float* sp = jb.src + (size_t)(k0 + ty + 8 * i) * jb.Nsrc;
          v[i][0] = sp[scA + tx]; v[i][1] = sp[scA + 64 + tx]; v[i][2] = sp[scB + tx]; v[i][3] = sp[scB + 64 + tx]; }
#pragma unroll
      for (int i = 0; i < 8; ++i) { const int kk = ty + 8 * i;
#pragma unroll
          for (int c = 0; c < 4; ++c) tl[kk * 257 + tx + 64 * c] = v[i][c]; } }
    __syncthreads();
    { const int i = tid >> 1, kh = tid & 1;
#pragma unroll
      for (int q = 0; q < 4; ++q) { float v[8];
#pragma unroll
          for (int e = 0; e < 8; ++e) v[e] = tl[(32 * kh + 8 * q + e) * 257 + i];
          u32x4 w; w.x = cvt_pk_bf16(v[0], v[1]); w.y = cvt_pk_bf16(v[2], v[3]); w.z = cvt_pk_bf16(v[4], v[5]); w.w = cvt_pk_bf16(v[6], v[7]);
          *(u32x4*)(jb.dst + (size_t)(r0 + i) * jb.K + k0 + 32 * kh + 8 * q) = w; } }
    __syncthreads();
}
DI void cvt_job(const float* src, bf16_t* dst, int K, int Nsrc, int Nt, int Hn, int& base, LAS float* tl, int vb, int G) {
    CvtJob jb{src, dst, K, Nsrc, Nt, Hn};
    const int ntile = (K / 64) * (Nt / 256);
    int first = (vb - base) % G; if (first < 0) first += G;
    for (int t = first; t < ntile; t += G) cvt_tile(jb, t, tl);
    base = (base + ntile) % G;
}
DI void cvt_first(const Params& p, LAS unsigned char* lds, int vb, int VG) {
    LAS float* tl = (LAS float*)lds; int base = 0;
    cvt_job(p.in[I_S5WIN], (bf16_t*)(p.ws + WS_W_S5IN), 1024, 1024, 1024, 0, base, tl, vb, VG);
}
DI void cvt_rest(const Params& p, LAS unsigned char* lds, int vb, int VG) {
    unsigned char* ws = p.ws;
    LAS float* tl = (LAS float*)lds;
    int base = 0;
    cvt_job(p.in[I_S5WOUT], (bf16_t*)(ws + WS_W_S5OUT), 1024, 2048, 2048, 1024, base, tl, vb, VG);
#pragma unroll 1
    for (int i = 0; i < 4; ++i) {
        cvt_job(p.in[I_WUP] + (size_t)i * 1024 * FF2, (bf16_t*)(ws + WS_W_UP) + (size_t)i * FF2 * 1024, 1024, FF2, FF2, FF, base, tl, vb, VG);
        cvt_job(p.in[I_WDN] + (size_t)i * FF * 1024, (bf16_t*)(ws + WS_W_DN) + (size_t)i * 1024 * FF, FF, 1024, 1024, 0, base, tl, vb, VG);
    }
#pragma unroll 1
    for (int j = 0; j < 2; ++j) {
        if (j == 1) {
            cvt_job(p.in[I_S5WIN] + (size_t)j * 1024 * 1024, (bf16_t*)(ws + WS_W_S5IN) + (size_t)j * 1024 * 1024, 1024, 1024, 1024, 0, base, tl, vb, VG);
            cvt_job(p.in[I_S5WOUT] + (size_t)j * 1024 * 2048, (bf16_t*)(ws + WS_W_S5OUT) + (size_t)j * 2048 * 1024, 1024, 2048, 2048, 1024, base, tl, vb, VG);
        }
        cvt_job(p.in[I_RGWIN] + (size_t)j * 1024 * 2048, (bf16_t*)(ws + WS_W_RGIN) + (size_t)j * 2048 * 1024, 1024, 2048, 2048, 0, base, tl, vb, VG);
        for (int nb = 0; nb < 4; ++nb)
            cvt_job(p.in[I_RGWG] + (size_t)(j * 4 + nb) * 256 * 512, (bf16_t*)(ws + WS_W_RGG) + (size_t)(j * 4 + nb) * 512 * 256, 256, 512, 512, 256, base, tl, vb, VG);
        cvt_job(p.in[I_RGWOUT] + (size_t)j * 1024 * 1024, (bf16_t*)(ws + WS_W_RGOUT) + (size_t)j * 1024 * 1024, 1024, 1024, 1024, 0, base, tl, vb, VG);
    }
}
DI void p0_phase(const Params& p, LAS unsigned char* lds) {
    unsigned char* ws = p.ws;
    cvt_first(p, lds, opaque_bid(), (int)gridDim.x);
    if (gridDim.x != 256) cvt_rest(p, lds, opaque_bid(), (int)gridDim.x);
    {
        const int tid = opaque_tid(); const int lane = tid & 63, gw = opaque_bid() * 8 + (tid >> 6), NGW = (int)gridDim.x * 8;
        bf16_t* H = (bf16_t*)(ws + WS_H);
        for (int row = gw; row < MA; row += NGW) {
            const float* src = nullptr;
            if (row < NSAMP) src = p.in[I_XS] + (size_t)row * D;
            else if (row < MT) { const int q = row - NSAMP, b = q / LP, t = q - b * LP; src = t < 16 ? p.in[I_META] + (size_t)t * D : p.in[I_XP] + ((size_t)b * 2048 + (t - 16)) * D; }
#pragma unroll
            for (int i = 0; i < 4; ++i) { const int c = 4 * lane + 256 * i; f32x4 v = (f32x4){0.f, 0.f, 0.f, 0.f}; if (src) v = ld4(src + c);
                u32x2 o; o.x = cvt_pk_bf16(v[0], v[1]); o.y = cvt_pk_bf16(v[2], v[3]); *(u32x2*)(H + (size_t)row * D + c) = o; }
        }
    }
    {
        const int gt = opaque_bid() * 512 + opaque_tid(), NT = (int)gridDim.x * 512;
        float* AB = (float*)(ws + WS_S5AB); bf16_t* BB = (bf16_t*)(ws + WS_S5BB); bf16_t* CC = (bf16_t*)(ws + WS_S5CC); float* SP = (float*)(ws + WS_RGSP);
        for (int it = gt; it < 2 * 64 * 64; it += NT) {
            const int pp = it & 63, g = (it >> 6) & 63, j = it >> 12; const int jg = j * 64 + g;
            const float step = expf(p.in[I_LOGSTEP][jg]); const float lr = p.in[I_LAMRE][jg * 64 + pp], li = p.in[I_LAMIM][jg * 64 + pp];
            const float mag = expf(lr * step); const float abr = mag * cosf(li * step), abi = mag * sinf(li * step);
            const float den = lr * lr + li * li, nr = abr - 1.0f, ni = abi;
            const float qr = (nr * lr + ni * li) / den, qi = (ni * lr - nr * li) / den;
            AB[(jg * 64 + pp) * 2] = abr; AB[(jg * 64 + pp) * 2 + 1] = abi;
            for (int h = 0; h < 16; ++h) {
                const float br = p.in[I_BRE][(size_t)(jg * 64 + pp) * 16 + h], bi = p.in[I_BIM][(size_t)(jg * 64 + pp) * 16 + h];
                BB[((size_t)(jg * 2 + 0) * 64 + pp) * 16 + h] = (bf16_t)(cvt_pk_bf16(qr * br - qi * bi, 0.f) & 0xffffu);
                BB[((size_t)(jg * 2 + 1) * 64 + pp) * 16 + h] = (bf16_t)(cvt_pk_bf16(qr * bi + qi * br, 0.f) & 0xffffu);
                const float cr = p.in[I_CRE][(size_t)(jg * 16 + h) * 64 + pp], ci = p.in[I_CIM][(size_t)(jg * 16 + h) * 64 + pp];
                *(unsigned*)(CC + (size_t)(jg * 16 + h) * 128 + 2 * pp) = cvt_pk_bf16(cr, -ci);
            }
        }
        for (int it = gt; it < 2 * 1024; it += NT) SP[it] = log1pf(expf(-p.in[I_RGLAM][it]));
        { pg8::StaticOrder S; S.init(69, 4, (int)gridDim.x, 0); const int nfull = (gridDim.x == 256) ? (S.nwg / S.G) * S.G : S.nwg; int* tmap = (int*)(ws + WS_TMAP);
          for (int L = gt; L < S.nwg; L += NT) { pg8::Unit u; S.unit(L, u); tmap[u.pm * 4 + u.pn] = (L >= nfull) ? (L - nfull) : -1; } }
    }
}

DI void ln_phase(const Params& p, int idx, bool fin, bool dry, int nsplit, const bf16_t* part, bool glu) {
    const int tid = opaque_tid(); const int lane = tid & 63, gw = opaque_bid() * 8 + (tid >> 6), NGW = (int)gridDim.x * 8;
    bf16_t* H = (bf16_t*)(p.ws + WS_H); const unsigned short* Z = (const unsigned short*)(p.ws + WS_Z);
    const float* gam = p.in[I_LNG] + (size_t)idx * D; const float* bet = p.in[I_LNB] + (size_t)idx * D;
    f32x4 gg[4], bb[4];
#pragma unroll
    for (int i = 0; i < 4; ++i) { gg[i] = ld4(gam + 4 * lane + 256 * i); bb[i] = ld4(bet + 4 * lane + 256 * i); }
    for (int rowa = gw; rowa < MT; rowa += 2 * NGW) {
        const int rowb = rowa + NGW; const bool hasb = rowb < MT;
        f32x4 vv[2][4];
#pragma unroll
        for (int i = 0; i < 4; ++i) { const u32x2 wa = *(const u32x2*)(Z + (size_t)rowa * D + 4 * lane + 256 * i); u32x2 wb; wb.x = 0u; wb.y = 0u; if (hasb) wb = *(const u32x2*)(Z + (size_t)rowb * D + 4 * lane + 256 * i);
            vv[0][i] = (f32x4){half_lo(wa.x), half_hi(wa.x), half_lo(wa.y), half_hi(wa.y)}; vv[1][i] = (f32x4){half_lo(wb.x), half_hi(wb.x), half_lo(wb.y), half_hi(wb.y)}; }
        if (nsplit && glu && gridDim.x == 256) {
#pragma unroll
            for (int rr = 0; rr < 2; ++rr) { const int row = rr ? rowb : rowa; if (rr == 1 && !hasb) break;
                if (row >= 64 * 256) {
                    u32x2 hw4[4];
#pragma unroll
                    for (int i = 0; i < 4; ++i) hw4[i] = *(const u32x2*)(H + (size_t)row * D + 4 * lane + 256 * i);
                    f32x4 sv[4], sg[4];
#pragma unroll
                    for (int i = 0; i < 4; ++i) { sv[i] = (f32x4){0.f, 0.f, 0.f, 0.f}; sg[i] = (f32x4){0.f, 0.f, 0.f, 0.f}; }
                    const int tb = ((row >> 8) - 64) * 8 + (lane >> 5), cc = (4 * lane) & 127;
                    for (int k = 0; k < nsplit; ++k) { u32x2 wv[4], wg[4];
#pragma unroll
                        for (int i = 0; i < 4; ++i) { const bf16_t* pp = part + ((size_t)((tb + 2 * i) * nsplit + k) * 256 + (row & 255)) * 256 + cc; wv[i] = *(const u32x2*)pp; wg[i] = *(const u32x2*)(pp + 128); }
#pragma unroll
                        for (int i = 0; i < 4; ++i) {
                            sv[i][0] += __uint_as_float(wv[i].x << 16); sv[i][1] += __uint_as_float(wv[i].x & 0xffff0000u); sv[i][2] += __uint_as_float(wv[i].y << 16); sv[i][3] += __uint_as_float(wv[i].y & 0xffff0000u);
                            sg[i][0] += __uint_as_float(wg[i].x << 16); sg[i][1] += __uint_as_float(wg[i].x & 0xffff0000u); sg[i][2] += __uint_as_float(wg[i].y << 16); sg[i][3] += __uint_as_float(wg[i].y & 0xffff0000u); } }
#pragma unroll
                    for (int i = 0; i < 4; ++i) { const f32x4 hb = (f32x4){__uint_as_float(hw4[i].x << 16), __uint_as_float(hw4[i].x & 0xffff0000u), __uint_as_float(hw4[i].y << 16), __uint_as_float(hw4[i].y & 0xffff0000u)} * ALPHA;
#pragma unroll
                        for (int e = 0; e < 4; ++e) vv[rr][i][e] = hb[e] + sv[i][e] * sigmoid_f(sg[i][e]); }
                }
            }
        } else if (nsplit && gridDim.x == 256) {
#pragma unroll
            for (int rr = 0; rr < 2; ++rr) { const int row = rr ? rowb : rowa; if (rr == 1 && !hasb) break;
                if (row >= 64 * 256) {
                    u32x2 hw4[4];
#pragma unroll
                    for (int i = 0; i < 4; ++i) hw4[i] = *(const u32x2*)(H + (size_t)row * D + 4 * lane + 256 * i);
#pragma unroll
                    for (int i = 0; i < 4; ++i) vv[rr][i] = (f32x4){__uint_as_float(hw4[i].x << 16), __uint_as_float(hw4[i].x & 0xffff0000u), __uint_as_float(hw4[i].y << 16), __uint_as_float(hw4[i].y & 0xffff0000u)} * ALPHA;
                    const int tb = ((row >> 8) - 64) * 4;
                    for (int k = 0; k < nsplit; ++k) { u32x2 w4[4];
#pragma unroll
                        for (int i = 0; i < 4; ++i) w4[i] = *(const u32x2*)(part + ((size_t)((tb + i) * nsplit + k) * 256 + (row & 255)) * 256 + 4 * lane);
#pragma unroll
                        for (int i = 0; i < 4; ++i) { vv[rr][i][0] += __uint_as_float(w4[i].x << 16); vv[rr][i][1] += __uint_as_float(w4[i].x & 0xffff0000u); vv[rr][i][2] += __uint_as_float(w4[i].y << 16); vv[rr][i][3] += __uint_as_float(w4[i].y & 0xffff0000u); } }
                }
            }
        }
#pragma unroll
        for (int rr = 0; rr < 2; ++rr) {
            if (rr == 1 && !hasb) break;
            const int row = rr ? rowb : rowa;
            float s = 0.f;
#pragma unroll
            for (int i = 0; i < 4; ++i) s += (vv[rr][i][0] + vv[rr][i][1]) + (vv[rr][i][2] + vv[rr][i][3]);
#pragma unroll
            for (int o = 32; o >= 1; o >>= 1) s += __shfl_xor(s, o);
            const float mu = s * (1.0f / 1024.0f); float q = 0.f;
#pragma unroll
            for (int i = 0; i < 4; ++i) { const f32x4 d = vv[rr][i] - mu; q += (d[0] * d[0] + d[1] * d[1]) + (d[2] * d[2] + d[3] * d[3]); }
#pragma unroll
            for (int o = 32; o >= 1; o >>= 1) q += __shfl_xor(q, o);
            const float rstd = 1.0f / sqrtf(q * (1.0f / 1024.0f) + LN_EPS);
            float* orow = nullptr;
            if (fin) { if (row < NSAMP) orow = p.out + O_YS + (size_t)row * D; else { const int qq = row - NSAMP, b = qq / LP, t = qq - b * LP; if (t >= 16) orow = p.out + O_YP + ((size_t)b * 2048 + (t - 16)) * D; } }
#pragma unroll
            for (int i = 0; i < 4; ++i) { const int c = 4 * lane + 256 * i; const f32x4 hn = (vv[rr][i] - mu) * rstd * gg[i] + bb[i];
                if (!fin) { u32x2 o; o.x = cvt_pk_bf16(hn[0], hn[1]); o.y = cvt_pk_bf16(hn[2], hn[3]); *(u32x2*)(H + (size_t)row * D + c) = o; }
                else if (orow) st4(orow + c, hn); }
        }
    }
}

DI void s5_phase(const Params& p, int j, LAS unsigned char* lds, int task0, int slot, int nslots) {
    const int tid = opaque_tid(), lane = tid & 63, wave = __builtin_amdgcn_readfirstlane(tid >> 6), r = lane & 31, hh = lane >> 5, c16 = lane & 15, q16 = lane >> 4;
    LAS unsigned char* img = lds + wave * 8704;
    const bf16_t* U = (const bf16_t*)(p.ws + WS_U); bf16_t* GY = (bf16_t*)(p.ws + WS_GY);
    const float* ABall = (const float*)(p.ws + WS_S5AB); const bf16_t* BBall = (const bf16_t*)(p.ws + WS_S5BB); const bf16_t* CCall = (const bf16_t*)(p.ws + WS_S5CC);
    const int tau = 16 * ((r >> 2) & 1) + 4 * (r >> 3) + (r & 3);
    for (int task = task0 + slot; task < 512 + 8192; task += nslots) {
        const bool pr = task < 512; int seq, g, L, row0;
        if (pr) { seq = task >> 6; g = task & 63; L = LP; row0 = NSAMP + seq * LP; } else { const int q = task - 512; seq = q >> 6; g = q & 63; L = 8; row0 = seq * 8; }
        const int jg = j * 64 + g;
        bf16x8 bfr[2][2];
#pragma unroll
        for (int s = 0; s < 2; ++s)
#pragma unroll
            for (int ri = 0; ri < 2; ++ri) bfr[s][ri] = *(const bf16x8*)(BBall + ((size_t)(jg * 2 + ri) * 64 + 32 * s + r) * 16 + 8 * hh);
        float ar[2], ai[2], cr[2], ci[2], fre[2] = {0.f, 0.f}, fim[2] = {0.f, 0.f};
#pragma unroll
        for (int s = 0; s < 2; ++s) { ar[s] = ABall[(jg * 64 + 32 * s + r) * 2]; ai[s] = ABall[(jg * 64 + 32 * s + r) * 2 + 1];
            if (pr) { cr[s] = 0.f; ci[s] = 0.f; } else { const size_t o = ((size_t)(j * 128 + seq) * 64 + g) * 64 + 32 * s + r; cr[s] = p.in[I_S5RE][o]; ci[s] = p.in[I_S5IM][o]; } }
        bf16x8 cfr[4];
#pragma unroll
        for (int ks = 0; ks < 4; ++ks) cfr[ks] = *(const bf16x8*)(CCall + (size_t)(jg * 16 + c16) * 128 + 32 * ks + 8 * q16);
        const float dsk = p.in[I_S5D][j * 1024 + 16 * g + c16];
        const int nch = (L + 31) >> 5;
        const bf16_t* ufp = U + (size_t)(row0 + tau) * D + 16 * g + 8 * hh;
        const bf16_t* usp = U + (size_t)(row0 + 4 * q16) * D + 16 * g + c16;
        bf16x8 uf_n = *(const bf16x8*)ufp; bf16_t us_n[8];
#pragma unroll
        for (int e = 0; e < 8; ++e) us_n[e] = usp[(size_t)(16 * (e >> 2) + (e & 3)) * D];
        for (int c = 0; c < nch; ++c) {
            const int t0 = 32 * c;
            const bf16x8 uf = uf_n; bf16_t us[8];
#pragma unroll
            for (int e = 0; e < 8; ++e) us[e] = us_n[e];
            if (c + 1 < nch) {
                uf_n = *(const bf16x8*)(ufp + (size_t)(t0 + 32) * D);
#pragma unroll
                for (int e = 0; e < 8; ++e) us_n[e] = usp[(size_t)(t0 + 32 + 16 * (e >> 2) + (e & 3)) * D];
            }
            f32x16 X[2][2];
#pragma unroll
            for (int s = 0; s < 2; ++s)
#pragma unroll
                for (int ri = 0; ri < 2; ++ri) { f32x16 z;
#pragma unroll
                    for (int i = 0; i < 16; ++i) z[i] = 0.f;
                    X[s][ri] = __builtin_amdgcn_mfma_f32_32x32x16_bf16(uf, bfr[s][ri], z, 0, 0, 0); }
#pragma unroll
            for (int s = 0; s < 2; ++s) {
                float sr = hh ? 0.f : cr[s], si = hh ? 0.f : ci[s];
#pragma unroll
                for (int i = 0; i < 16; ++i) {
                    float nr = fmaf(ar[s], sr, X[s][0][i]); nr = fmaf(-ai[s], si, nr);
                    float ni = fmaf(ar[s], si, X[s][1][i]); ni = fmaf(ai[s], sr, ni);
                    sr = nr; si = ni; X[s][0][i] = sr; X[s][1][i] = si;
                }
                if (c == nch - 1) { fre[s] = pr ? X[s][0][15] : X[s][0][7]; fim[s] = pr ? X[s][1][15] : X[s][1][7]; }
                const float er = __shfl(X[s][0][15], r), ei = __shfl(X[s][1][15], r);
                float xr = hh ? er : 0.f, xi = hh ? ei : 0.f;
#pragma unroll
                for (int i = 0; i < 16; ++i) {
                    const float tr = ar[s] * xr - ai[s] * xi, ti = ar[s] * xi + ai[s] * xr; xr = tr; xi = ti;
                    X[s][0][i] += xr; X[s][1][i] += xi;
                }
                cr[s] = __shfl(X[s][0][15], 32 + r); ci[s] = __shfl(X[s][1][15], 32 + r);
#pragma unroll
                for (int i = 0; i < 16; ++i) *(LAS unsigned*)(img + (16 * hh + i) * 272 + 4 * (32 * s + r)) = cvt_pk_bf16(X[s][0][i], X[s][1][i]);
            }
            asm volatile("s_waitcnt lgkmcnt(0)" ::: "memory");
            f32x4 Dm[2] = {(f32x4){0.f, 0.f, 0.f, 0.f}, (f32x4){0.f, 0.f, 0.f, 0.f}};
#pragma unroll
            for (int mb = 0; mb < 2; ++mb)
#pragma unroll
                for (int ks = 0; ks < 4; ++ks) { const bf16x8 a = *(const LAS bf16x8*)(img + (16 * mb + c16) * 272 + (32 * ks + 8 * q16) * 2);
                    Dm[mb] = __builtin_amdgcn_mfma_f32_16x16x32_bf16(a, cfr[ks], Dm[mb], 0, 0, 0); }
#pragma unroll
            for (int mb = 0; mb < 2; ++mb)
#pragma unroll
                for (int rg = 0; rg < 4; ++rg) { const int t = t0 + 16 * mb + 4 * q16 + rg;
                    if (t < L) { const size_t off = (size_t)(row0 + t) * D + 16 * g + c16; const float y = Dm[mb][rg] + dsk * bf2f(us[4 * mb + rg]); GY[off] = (bf16_t)(cvt_pk_bf16(gelu_f(y), 0.f) & 0xffffu); } }
            asm volatile("s_waitcnt lgkmcnt(0)" ::: "memory");
        }
        if (hh == 0) {
            float* ore = p.out + (pr ? O_S5RP : O_S5RS); float* oim = p.out + (pr ? O_S5IP : O_S5IS);
            const size_t o = ((size_t)(j * (pr ? 8 : 128) + seq) * 64 + g) * 64 + r;
            ore[o] = fre[0]; ore[o + 32] = fre[1]; oim[o] = fim[0]; oim[o + 32] = fim[1];
        }
    }
}


DI void s5_pair_long(const Params& p, int j, LAS unsigned char* lds) {
    const int tid = opaque_tid(), lane = tid & 63, wave = __builtin_amdgcn_readfirstlane(tid >> 6), r = lane & 31, hh = lane >> 5, c16 = lane & 15, q16 = lane >> 4;
    const int s = wave & 1, pairi = wave >> 1;
    const int task = opaque_bid() * 4 + pairi;
    LAS unsigned char* img0 = lds + pairi * (2 * 8704);
    const bf16_t* U = (const bf16_t*)(p.ws + WS_U); bf16_t* GY = (bf16_t*)(p.ws + WS_GY);
    const float* ABall = (const float*)(p.ws + WS_S5AB); const bf16_t* BBall = (const bf16_t*)(p.ws + WS_S5BB); const bf16_t* CCall = (const bf16_t*)(p.ws + WS_S5CC);
    const int tau = 16 * ((r >> 2) & 1) + 4 * (r >> 3) + (r & 3);
    const int seq = task >> 6, g = task & 63, row0 = NSAMP + seq * LP, jg = j * 64 + g;
    bf16x8 bfr[2];
#pragma unroll
    for (int ri = 0; ri < 2; ++ri) bfr[ri] = *(const bf16x8*)(BBall + ((size_t)(jg * 2 + ri) * 64 + 32 * s + r) * 16 + 8 * hh);
    const float ar = ABall[(jg * 64 + 32 * s + r) * 2], ai = ABall[(jg * 64 + 32 * s + r) * 2 + 1];
    float cr = 0.f, ci = 0.f, fre = 0.f, fim = 0.f;
    bf16x8 cfr[4];
#pragma unroll
    for (int ks = 0; ks < 4; ++ks) cfr[ks] = *(const bf16x8*)(CCall + (size_t)(jg * 16 + c16) * 128 + 32 * ks + 8 * q16);
    const float dsk = p.in[I_S5D][j * 1024 + 16 * g + c16];
    constexpr int nch = (LP + 31) >> 5;
    const bf16_t* ufp = U + (size_t)(row0 + tau) * D + 16 * g + 8 * hh;
    const bf16_t* usp = U + (size_t)(row0 + 16 * s + 4 * q16) * D + 16 * g + c16;
    bf16x8 uf_n = *(const bf16x8*)ufp; bf16_t us_n[4];
#pragma unroll
    for (int e = 0; e < 4; ++e) us_n[e] = usp[(size_t)e * D];
#pragma unroll 1
    for (int c = 0; c < nch; ++c) {
        const int t0 = 32 * c;
        LAS unsigned char* img = img0 + (c & 1) * 8704;
        const bf16x8 uf = uf_n; bf16_t us[4];
#pragma unroll
        for (int e = 0; e < 4; ++e) us[e] = us_n[e];
        if (c + 1 < nch) {
            uf_n = *(const bf16x8*)(ufp + (size_t)(t0 + 32) * D);
#pragma unroll
            for (int e = 0; e < 4; ++e) us_n[e] = usp[(size_t)(t0 + 32 + e) * D];
        }
        f32x16 X[2];
#pragma unroll
        for (int ri = 0; ri < 2; ++ri) { f32x16 z;
#pragma unroll
            for (int i = 0; i < 16; ++i) z[i] = 0.f;
            X[ri] = __builtin_amdgcn_mfma_f32_32x32x16_bf16(uf, bfr[ri], z, 0, 0, 0); }
        {
            float sr = hh ? 0.f : cr, si = hh ? 0.f : ci;
#pragma unroll
            for (int i = 0; i < 16; ++i) {
                float nr = fmaf(ar, sr, X[0][i]); nr = fmaf(-ai, si, nr);
                float ni = fmaf(ar, si, X[1][i]); ni = fmaf(ai, sr, ni);
                sr = nr; si = ni; X[0][i] = sr; X[1][i] = si;
            }
            if (c == nch - 1) { fre = X[0][15]; fim = X[1][15]; }
            const auto sw0 = __builtin_amdgcn_permlane32_swap(__float_as_uint(X[0][15]), __float_as_uint(X[0][15]), false, false);
            const auto sw1 = __builtin_amdgcn_permlane32_swap(__float_as_uint(X[1][15]), __float_as_uint(X[1][15]), false, false);
            const float er = __uint_as_float(sw0[0]), ei = __uint_as_float(sw1[0]);
            float xr = hh ? er : 0.f, xi = hh ? ei : 0.f;
#pragma unroll
            for (int i = 0; i < 16; ++i) {
                const float tr = ar * xr - ai * xi, ti = ar * xi + ai * xr; xr = tr; xi = ti;
                X[0][i] += xr; X[1][i] += xi;
            }
            { const auto cw0 = __builtin_amdgcn_permlane32_swap(__float_as_uint(X[0][15]), __float_as_uint(X[0][15]), false, false);
              const auto cw1 = __builtin_amdgcn_permlane32_swap(__float_as_uint(X[1][15]), __float_as_uint(X[1][15]), false, false);
              cr = __uint_as_float(cw0[1]); ci = __uint_as_float(cw1[1]); }
#pragma unroll
            for (int i = 0; i < 16; ++i) *(LAS unsigned*)(img + (16 * hh + i) * 272 + 4 * (32 * s + r)) = cvt_pk_bf16(X[0][i], X[1][i]);
        }
        asm volatile("s_waitcnt lgkmcnt(0)" ::: "memory");
        __syncthreads();
        f32x4 Dm = (f32x4){0.f, 0.f, 0.f, 0.f};
#pragma unroll
        for (int ks = 0; ks < 4; ++ks) { const bf16x8 a = *(const LAS bf16x8*)(img + (16 * s + c16) * 272 + (32 * ks + 8 * q16) * 2);
            Dm = __builtin_amdgcn_mfma_f32_16x16x32_bf16(a, cfr[ks], Dm, 0, 0, 0); }
#pragma unroll
        for (int rg = 0; rg < 4; ++rg) { const int t = t0 + 16 * s + 4 * q16 + rg;
            if (t < LP) { const size_t off = (size_t)(row0 + t) * D + 16 * g + c16; const float y = Dm[rg] + dsk * bf2f(us[rg]); GY[off] = (bf16_t)(cvt_pk_bf16(gelu_f(y), 0.f) & 0xffffu); } }
    }
    if (hh == 0) {
        const size_t o = ((size_t)(j * 8 + seq) * 64 + g) * 64 + 32 * s + r;
        p.out[O_S5RP + o] = fre; p.out[O_S5IP + o] = fim;
    }
}

DI void rg_scan_a(const Params& p) {
    const int tid = opaque_tid(); const int lane = tid & 63, gw = opaque_bid() * 8 + (tid >> 6), NGW = (int)gridDim.x * 8;
    const unsigned* AB = (const unsigned*)(p.ws + WS_AB); float* RS = (float*)(p.ws + WS_RSUM);
    for (int task = gw; task < 274 * 16; task += NGW) {
        const int chunk = task >> 4, ch = 64 * (task & 15) + lane;
        unsigned w[64];
#pragma unroll
        for (int i = 0; i < 64; ++i) w[i] = AB[(size_t)(64 * chunk + i) * D + ch];
        float A = 1.f, B = 0.f;
#pragma unroll
        for (int i = 0; i < 64; ++i) { const float a = __builtin_amdgcn_exp2f(half_lo(w[i])); B = fmaf(a, B, half_hi(w[i])); A *= a; }
        *(float2*)(RS + ((size_t)chunk * D + ch) * 2) = make_float2(A, B);
    }
}
DI void rg_scan_b(const Params& p, int j) {
    const int tid = opaque_tid(); const int lane = tid & 63, gw = opaque_bid() * 8 + (tid >> 6), NGW = (int)gridDim.x * 8;
    const unsigned* AB = (const unsigned*)(p.ws + WS_AB); const float* RS = (const float*)(p.ws + WS_RSUM);
    const bf16_t* GATE = (const bf16_t*)(p.ws + WS_GATE); bf16_t* Y = (bf16_t*)(p.ws + WS_XC);
    for (int task = gw; task < 274 * 16; task += NGW) {
        const int chunk = task >> 4, ch = 64 * (task & 15) + lane;
        float h = 0.f;
        {
            float2 ab[33];
#pragma unroll
            for (int i = 0; i < 33; ++i) { const int k = chunk - 33 + i; ab[i] = (k >= 0) ? *(const float2*)(RS + ((size_t)k * D + ch) * 2) : make_float2(1.f, 0.f); }
#pragma unroll
            for (int i = 0; i < 33; ++i) h = fmaf(ab[i].x, h, ab[i].y);
        }
        asm volatile("" ::: "memory");
#pragma unroll 1
        for (int hf = 0; hf < 2; ++hf) {
            const int rbase = 64 * chunk + 32 * hf;
            unsigned w[32]; bf16_t gt[32];
#pragma unroll
            for (int i = 0; i < 32; ++i) { w[i] = AB[(size_t)(rbase + i) * D + ch]; gt[i] = GATE[(size_t)(rbase + i) * D + ch]; }
#pragma unroll
            for (int i = 0; i < 32; ++i) {
                const int row = rbase + i;
                h = fmaf(__builtin_amdgcn_exp2f(half_lo(w[i])), h, half_hi(w[i]));
                Y[(size_t)row * D + ch] = (bf16_t)(cvt_pk_bf16(h * bf2f(gt[i]), 0.f) & 0xffffu);
                if (row < NSAMP) { if ((row & 7) == 7) p.out[O_RGHS + ((size_t)j * 128 + (row >> 3)) * D + ch] = h; }
                else { const int q = row - NSAMP, b = q / LP, t = q - b * LP; if (t == LP - 1) p.out[O_RGHP + ((size_t)j * 8 + b) * D + ch] = h; }
            }
            asm volatile("" ::: "memory");
        }
    }
}

#define XB_TMO      128
#define XB_XCNT(j)  (256  + 64 * (j))
#define XB_XSUB(j)  (1280 + 64 * (j))
#define XB_XGEN(j)  (2304 + 64 * (j))
#define XB_TOP      3328
#define XB_TOPGEN   3392
#define XCD_BAR_WORDS 3456
#define XB_SPIN_CAP (1u << 20)
DI unsigned xb_ld(unsigned* p)              { return __hip_atomic_load(p, __ATOMIC_RELAXED, __HIP_MEMORY_SCOPE_AGENT); }
DI unsigned xb_add(unsigned* p, unsigned v) { return __hip_atomic_fetch_add(p, v, __ATOMIC_RELAXED, __HIP_MEMORY_SCOPE_AGENT); }
DI unsigned xb_xcc_id() { return (unsigned)__builtin_amdgcn_s_getreg((3 << 11) | 20) & 0xFu; }
#define XB_SPIN(cond, bar) do { unsigned _sp = 0; while (cond) { __builtin_amdgcn_s_sleep(1); \
    if ((++_sp & 255u) == 0u) { if (xb_ld(&(bar)[XB_TMO])) break; if (_sp > XB_SPIN_CAP) { atomicAdd(&(bar)[XB_TMO], 1u); break; } } } } while (0)
struct XcdBarrier { unsigned* bar; unsigned x; volatile LAS unsigned* st; };
DI XcdBarrier xcd_barrier_post(unsigned* bar, volatile LAS unsigned* st) {
    XcdBarrier b; b.bar = bar; b.x = xb_xcc_id(); b.st = st;
    if (threadIdx.x == 0) (void)xb_add(&bar[XB_XCNT(b.x)], 1u);
    return b;
}
DI void xcd_barrier_complete(unsigned* bar, unsigned x, unsigned& nloc, unsigned& nx) {
    const unsigned G = gridDim.x * gridDim.y * gridDim.z;
    unsigned sum, cnt, mine, sp = 0u;
    for (;;) {
        sum = 0u; cnt = 0u; mine = 0u;
#pragma unroll
        for (unsigned j = 0; j < 16; ++j) { const unsigned c = xb_ld(&bar[XB_XCNT(j)]); sum += c; cnt += (c > 0u) ? 1u : 0u; mine = (j == x) ? c : mine; }
        if (sum == G) break;
        __builtin_amdgcn_s_sleep(1);
        if ((++sp & 255u) == 0u) { if (xb_ld(&bar[XB_TMO])) break; if (sp > XB_SPIN_CAP) { atomicAdd(&bar[XB_TMO], 1u); break; } }
    }
    nloc = mine > 0u ? mine : 1u; nx = cnt > 0u ? cnt : 1u;
}
DI void xcd_barrier(const XcdBarrier& b) {
    asm volatile("s_waitcnt vmcnt(0)" ::: "memory");
    __syncthreads();
    if (threadIdx.x == 0) {
        unsigned* bar = b.bar;
        __builtin_amdgcn_s_waitcnt(0);
        unsigned nloc = b.st[0], nx = b.st[1];
        if (nloc == 0u) { xcd_barrier_complete(bar, b.x, nloc, nx); b.st[0] = nloc; b.st[1] = nx; }
        const unsigned old = xb_add(&bar[XB_XSUB(b.x)], 1u);
        const unsigned gen = old / nloc;
        if (old + 1u == (gen + 1u) * nloc) {
            __builtin_amdgcn_fence(__ATOMIC_RELEASE, "agent");
            asm volatile("s_waitcnt vmcnt(0)" ::: "memory");
            const unsigned og = xb_add(&bar[XB_TOP], 1u);
            const unsigned tg = og / nx;
            if (og + 1u == (tg + 1u) * nx) xb_add(&bar[XB_TOPGEN], 1u);
            else XB_SPIN(xb_ld(&bar[XB_TOPGEN]) == tg, bar);
            __builtin_amdgcn_fence(__ATOMIC_ACQUIRE, "agent");
            xb_add(&bar[XB_XGEN(b.x)], 1u);
            asm volatile("s_waitcnt vmcnt(0)" ::: "memory");
        } else {
            XB_SPIN(xb_ld(&bar[XB_XGEN(b.x)]) == gen, bar);
            __builtin_amdgcn_fence(__ATOMIC_ACQUIRE, "agent");
            asm volatile("s_waitcnt vmcnt(0)" ::: "memory");
        }
    }
    __syncthreads();
}

constexpr int LDS_BYTES = pg8::STAGE_BYTES + 4096 + 10240;
__global__ void __launch_bounds__(512, 2) fwd_megakernel(Params p) {
    extern __shared__ __attribute__((aligned(16))) unsigned char lds_raw[];
    LAS unsigned char* lds = (LAS unsigned char*)lds_raw;
    cg::grid_group grid = cg::this_grid();
    unsigned char* ws = p.ws;
    bf16_t* H = (bf16_t*)(ws + WS_H); unsigned short* Z = (unsigned short*)(ws + WS_Z);

    if (threadIdx.x < 4) ((LAS unsigned*)(lds + pg8::STAGE_BYTES + 3072))[threadIdx.x] = 0u;
    __syncthreads();
    if (blockIdx.x == 0) for (int k = threadIdx.x; k < XCD_BAR_WORDS; k += 512) __hip_atomic_store((unsigned*)(ws + WS_BAR) + k, 0u, __ATOMIC_RELAXED, __HIP_MEMORY_SCOPE_AGENT);
    p0_phase(p, lds);
    grid.sync();
    const XcdBarrier xbar = xcd_barrier_post((unsigned*)(ws + WS_BAR), (volatile LAS unsigned*)(lds + pg8::STAGE_BYTES + 3072));
#pragma unroll 1
    for (int i = 0; i < 4; ++i) {
        const int j = i >> 1;
        if ((i & 1) == 0) {
            { pg8::Gemm g{H, (const bf16_t*)(ws + WS_W_S5IN) + (size_t)j * 1024 * 1024};
              EpiStoreBf16 E{(bf16_t*)(ws + WS_U), D}; for (int rep = 0; rep < (DUP_G1 ? 2 : 1); ++rep) { if (rep) GSYNC(); pg8::gemm_phase<EpiStoreBf16, false, pg8::GC<D, 1024, 1024, 69, 4, 256, 0>>(lds, g, E); } }
            GSYNC();
            for (int rep = 0; rep < (DUP_S5 ? 2 : 1); ++rep) {
                if (rep) GSYNC();
                const int wv = __builtin_amdgcn_readfirstlane(threadIdx.x >> 6);
                if (gridDim.x == 256) { if (blockIdx.x < 128) s5_pair_long(p, j, lds); else { s5_phase(p, j, lds, 512, wv * 128 + ((int)blockIdx.x - 128), 1024); if (i == 0) { __syncthreads(); cvt_rest(p, lds, (int)blockIdx.x - 128, 128); } } }
                else s5_phase(p, j, lds, 0, wv * (int)gridDim.x + (int)blockIdx.x, 8 * (int)gridDim.x);
            }
            GSYNC();
            { pg8::Gemm g{(const bf16_t*)(ws + WS_GY), (const bf16_t*)(ws + WS_W_S5OUT) + (size_t)j * 2048 * 1024};
              EpiGluRes E{Z, H, (bf16_t*)(ws + WS_PART_RG)}; pg8::gemm_phase<EpiGluRes, false, pg8::GC<D, 1024, 1024, 69, 8, 256, 0>, 4>(lds, g, E); }
            GSYNC();
        } else {
            { pg8::Gemm g{H, (const bf16_t*)(ws + WS_W_RGIN) + (size_t)j * 2048 * 1024};
              EpiRgIn E{j};
              for (int rep = 0; rep < (DUP_RG ? 2 : 1); ++rep) { if (rep) GSYNC(); pg8::gemm_phase<EpiRgIn, true, pg8::GC<D, 1024, 1024, 70, 8, 253, 0>>(lds, g, E); } }
            GSYNC();
            { pg8::Gemm g{(const bf16_t*)(ws + WS_XC), (const bf16_t*)(ws + WS_W_RGG) + (size_t)j * 2048 * 256};
              EpiRgGates E{(const bf16_t*)(ws + WS_XC), (unsigned*)(ws + WS_AB), p.in[I_RGBG] + (size_t)j * 2048, (const float*)(ws + WS_RGSP) + (size_t)j * 1024, p.in[I_RGH] + (size_t)j * 128 * D};
              for (int rep = 0; rep < (DUP_RG ? 2 : 1); ++rep) { if (rep) GSYNC(); pg8::gemm_phase<EpiRgGates, false, pg8::GC<D, 256, 256, 69, 8, 256, 1>>(lds, g, E); } }
            GSYNC();
            rg_scan_a(p);
            if (DUP_SCAN) { GSYNC(); rg_scan_a(p); }
            GSYNC();
            rg_scan_b(p, j);
            if (DUP_SCAN) { GSYNC(); rg_scan_b(p, j); }
            GSYNC();
            { pg8::Gemm g{(const bf16_t*)(ws + WS_XC), (const bf16_t*)(ws + WS_W_RGOUT) + (size_t)j * 1024 * 1024};
              EpiAddZ E{Z, (bf16_t*)(ws + WS_PART_RG), H}; pg8::gemm_phase<EpiAddZ, false, pg8::GC<D, 1024, 1024, 69, 4, 256, 0>, 4>(lds, g, E); }
            GSYNC();
        }
        ln_phase(p, 2 * i, false, false, 4, (const bf16_t*)(ws + WS_PART_RG), (i & 1) == 0);
        GSYNC();
        { pg8::Gemm g{H, (const bf16_t*)(ws + WS_W_UP) + (size_t)i * FF2 * 1024};
          EpiFfnUp E{i};
          for (int rep = 0; rep < (DUP_UP ? 2 : 1); ++rep) { if (rep) GSYNC(); pg8::gemm_phase<EpiFfnUp, true, pg8::GC<D, 1024, 1024, 69, 22, 254, 0>>(lds, g, E); } }
        GSYNC();
        { pg8::Gemm g{(const bf16_t*)(ws + WS_ACT), (const bf16_t*)(ws + WS_W_DN) + (size_t)i * 1024 * FF};
          EpiAddZ E{Z, (bf16_t*)(ws + WS_PART_FFN), H}; pg8::gemm_phase<EpiAddZ, false, pg8::GC<FF, FF, FF, 69, 4, 256, 0>, 11>(lds, g, E); }
        GSYNC();
        ln_phase(p, 2 * i + 1, i == 3, false, 11, (const bf16_t*)(ws + WS_PART_FFN), false);
        if (i < 3) GSYNC();
    }
}

extern "C" void kernel_launch(void* const* d_in, const int* in_sizes, int n_in, void* d_out, int out_size, void* d_ws, size_t ws_size, hipStream_t stream) {
    static int grid_blocks = 0;
    if (grid_blocks == 0) {
        if (n_in != 31 || ws_size < WS_END) { fprintf(stderr, "kernel_launch: unexpected inputs (n_in %d, ws %zu, need %zu)\n", n_in, ws_size, (size_t)WS_END); grid_blocks = -1; return; }
        int dev = 0, cus = 0, per_cu = 0;
        hipGetDevice(&dev);
        hipDeviceGetAttribute(&cus, hipDeviceAttributeMultiprocessorCount, dev);
        hipFuncSetAttribute((const void*)fwd_megakernel, hipFuncAttributeMaxDynamicSharedMemorySize, LDS_BYTES);
        hipOccupancyMaxActiveBlocksPerMultiprocessor(&per_cu, (const void*)fwd_megakernel, 512, LDS_BYTES);
        if (per_cu < 1) per_cu = 1;
        grid_blocks = cus * 1;
        (void)hipGetLastError();
    }
    if (grid_blocks < 0) return;
    Params p{};
    for (int i = 0; i < 31; ++i) p.in[i] = (const float*)d_in[i];
    p.out = (float*)d_out; p.ws = (unsigned char*)d_ws;
    void* args[] = {&p};
    hipError_t e = hipLaunchCooperativeKernel((const void*)fwd_megakernel, dim3(grid_blocks), dim3(512), args, LDS_BYTES, stream);
    if (e != hipSuccess) fprintf(stderr, "cooperative launch failed: %s (grid %d)\n", hipGetErrorString(e), grid_blocks);
}
```

```cpp
#include <hip/hip_runtime.h>
#include <hip/hip_cooperative_groups.h>
#include <cstdio>
namespace cg = cooperative_groups;
#define DUP_SYNC 0
#define DUP_P0 0
#define DUP_S5 0
#define DUP_SCAN 0
#define DUP_UP 0
#define DUP_RG 0
#define DUP_LN 0
#define DUP_G1 0
#define GSYNC() do { xcd_barrier(xbar); if (DUP_SYNC) xcd_barrier(xbar); } while (0)

#define LAS __attribute__((address_space(3)))
typedef unsigned short bf16_t;
typedef short bf16x8 __attribute__((ext_vector_type(8)));
typedef float f32x4 __attribute__((ext_vector_type(4)));
typedef float f32x16 __attribute__((ext_vector_type(16)));
typedef unsigned u32x4 __attribute__((ext_vector_type(4)));
typedef unsigned u32x2 __attribute__((ext_vector_type(2)));
#define DI __device__ __forceinline__

constexpr int D = 1024, FF = 2816, FF2 = 5632;
constexpr int NSAMP = 1024;
constexpr int LP = 2064;
constexpr int MT = 17536;
constexpr int MA = 17792;
constexpr float ALPHA = 1.6817928305074290f;
constexpr float LN_EPS = 1e-5f;

constexpr size_t SZ_ROWS_BF = (size_t)MA * 1024 * 2;
constexpr size_t WS_W_S5IN = 0;
constexpr size_t WS_W_S5OUT = WS_W_S5IN + (size_t)2 * 1024 * 1024 * 2;
constexpr size_t WS_W_RGIN = WS_W_S5OUT + (size_t)2 * 2048 * 1024 * 2;
constexpr size_t WS_W_RGG = WS_W_RGIN + (size_t)2 * 2048 * 1024 * 2;
constexpr size_t WS_W_RGOUT = WS_W_RGG + (size_t)2 * 2048 * 256 * 2;
constexpr size_t WS_W_UP = WS_W_RGOUT + (size_t)2 * 1024 * 1024 * 2;
constexpr size_t WS_W_DN = WS_W_UP + (size_t)4 * 5632 * 1024 * 2;
constexpr size_t WS_H = WS_W_DN + (size_t)4 * 1024 * 2816 * 2;
constexpr size_t WS_Z = WS_H + SZ_ROWS_BF;
constexpr size_t WS_BIG = WS_Z + (size_t)MA * 1024 * 4;
constexpr size_t WS_U = WS_BIG, WS_GY = WS_BIG + SZ_ROWS_BF;
constexpr size_t WS_ACT = WS_BIG;
constexpr size_t WS_GATE = WS_BIG, WS_XC = WS_BIG + SZ_ROWS_BF, WS_AB = WS_BIG + 2 * SZ_ROWS_BF;
constexpr size_t WS_SMALL = WS_BIG + 2 * SZ_ROWS_BF + (size_t)MA * 1024 * 4;
constexpr size_t WS_S5AB = WS_SMALL;
constexpr size_t WS_S5BB = WS_S5AB + 65536;
constexpr size_t WS_S5CC = WS_S5BB + 524288;
constexpr size_t WS_RGSP = WS_S5CC + 524288;
constexpr size_t WS_RSUM = WS_RGSP + 8192;
constexpr size_t WS_BAR = WS_RSUM + (size_t)548 * 1024 * 8;
constexpr size_t WS_TMAP = WS_BAR + 16384;
constexpr size_t WS_END = WS_TMAP + 2048;
constexpr size_t WS_PART_FFN = WS_BIG + (size_t)MA * FF * 2;
constexpr size_t WS_PART_RG = WS_AB;
static_assert(WS_PART_FFN + (size_t)220 * 131072 <= WS_SMALL, "partials must fit behind ACT");

constexpr size_t O_YP = 0, O_YS = O_YP + 16777216, O_S5RP = O_YS + 1048576, O_S5IP = O_S5RP + 65536, O_RGHP = O_S5IP + 65536,
                 O_RGCP = O_RGHP + 16384, O_FFCP = O_RGCP + 49152, O_S5RS = O_FFCP + 360448, O_S5IS = O_S5RS + 1048576,
                 O_RGHS = O_S5IS + 1048576, O_RGCS = O_RGHS + 262144, O_FFCS = O_RGCS + 786432;

struct Params { const float* in[31]; float* out; unsigned char* ws; };
typedef const Params __attribute__((address_space(4))) KParams;
DI const KParams* kparams() { const KParams* kp = (const KParams*)__builtin_amdgcn_kernarg_segment_ptr(); asm volatile("" : "+s"(kp)); return kp; }
enum { I_XP = 0, I_XS, I_S5RE, I_S5IM, I_RGH, I_RGCONV, I_FFCONV, I_META, I_S5WIN, I_LAMRE, I_LAMIM, I_LOGSTEP, I_BRE, I_BIM, I_CRE, I_CIM, I_S5D,
       I_S5WOUT, I_RGWIN, I_RGCW, I_RGCB, I_RGWG, I_RGBG, I_RGLAM, I_RGWOUT, I_WUP, I_FCW, I_FCB, I_WDN, I_LNG, I_LNB };

DI int opaque_tid() { int t = threadIdx.x; asm volatile("" : "+v"(t)); return t; }
DI int opaque_bid() { int b = blockIdx.x; asm volatile("" : "+s"(b)); return b; }
DI unsigned cvt_pk_bf16(float lo, float hi) { unsigned r; asm volatile("v_cvt_pk_bf16_f32 %0, %1, %2" : "=v"(r) : "v"(lo), "v"(hi)); return r; }
DI float bf2f(bf16_t b) { return __uint_as_float(((unsigned)b) << 16); }
DI float sigmoid_f(float x) { return __builtin_amdgcn_rcpf(1.0f + __builtin_amdgcn_exp2f(-1.4426950408889634f * x)); }
DI float gelu_f(float x) {
    const float u = x * (1.0f + 0.044715f * x * x);
    return x * __builtin_amdgcn_rcpf(1.0f + __builtin_amdgcn_exp2f(-2.3022081989f * u));
}
DI f32x4 ld4(const float* p) { return *(const f32x4*)p; }
DI void st4(float* p, f32x4 v) { *(f32x4*)p = v; }
DI unsigned pk_half2(float lo, float hi) { const _Float16 a = (_Float16)lo, b = (_Float16)hi; return (unsigned)__builtin_bit_cast(unsigned short, a) | ((unsigned)__builtin_bit_cast(unsigned short, b) << 16); }
DI float half_lo(unsigned w) { return (float)__builtin_bit_cast(_Float16, (unsigned short)(w & 0xffffu)); }
DI float half_hi(unsigned w) { return (float)__builtin_bit_cast(_Float16, (unsigned short)(w >> 16)); }

namespace pg8 {
constexpr int BM = 256, BK = 64, HALF = 128, HTB = HALF * BK * 2, STAGE_BYTES = 8 * HTB, NXCD = 8, WGM = 4;
DI int lds_byte(int r, int c) { const int st = (r >> 4) * 2 + (c >> 5), rr = r & 15, cc = c & 31, ob = rr * 64 + cc * 2; return st * 1024 + (ob ^ (((ob >> 9) & 1) << 5)); }
DI void stage_rc(int b, int& R, int& C) { const int st = b / 1024, sb = b % 1024, swz = sb ^ (((sb >> 9) & 1) << 5); R = (st >> 1) * 16 + swz / 64; C = (st & 1) * 32 + (swz % 64) / 2; }
DI int perm32(int rho) { const int n = rho >> 4, i = rho & 15; return 8 * (i >> 2) + 4 * n + (i & 3); }
struct Unit { int pm, pn; };
struct Gemm { const bf16_t* A; const bf16_t* Bt; };
template <int LDA_, int LDB_, int K_, int NM_, int NN_, int RSTRIDE_, int ACOL_> struct GC { static constexpr int lda = LDA_, ldb = LDB_, K = K_, nM = NM_, nN = NN_, rstride = RSTRIDE_, acolmode = ACOL_; };
struct StaticOrder {
    int nM, nN, nwg, G, c;
    DI void init(int nM_, int nN_, int G_, int c_) { nM = nM_; nN = nN_; nwg = nM * nN; G = G_; c = c_; }
    DI void unit(int Lu, Unit& u) const {
        int wgid = Lu; { const int q = nwg / NXCD, r = nwg % NXCD, xcd = wgid % NXCD, off = wgid / NXCD; wgid = (xcd < r ? xcd * (q + 1) : r * (q + 1) + (xcd - r) * q) + off; }
        const int nig = WGM * nN, gid = wgid / nig, fm = gid * WGM, gsz = (nM - fm) < WGM ? (nM - fm) : WGM;
        u.pm = fm + ((wgid % nig) % gsz); u.pn = (wgid % nig) / gsz;
    }
    DI bool next_item(int i, int nfull, int nitems, int nsplit, Unit& u, int& piece, int& kpart) const {
        const long L = (long)i * G + c; if (L >= nitems) return false;
        int Lu = (int)L; piece = -1; kpart = 0;
        if (nfull == nwg) { unit(Lu, u); return true; }
        if (Lu >= nfull) { const int q = Lu - nfull; piece = q; kpart = q % nsplit; const int t = q / nsplit; u.pm = nfull / nN + t / nN; u.pn = t % nN; return true; }
        StaticOrder Sf; Sf.init(nfull / nN, nN, G, c); Sf.unit(Lu, u); return true;
    }
    DI bool next(int i, Unit& u) const {
        const long L = (long)i * G + c; if (L >= nwg) return false;
        int wgid = (int)L; { const int q = nwg / NXCD, r = nwg % NXCD, xcd = wgid % NXCD, off = wgid / NXCD; wgid = (xcd < r ? xcd * (q + 1) : r * (q + 1) + (xcd - r) * q) + off; }
        const int nig = WGM * nN, gid = wgid / nig, fm = gid * WGM, gsz = (nM - fm) < WGM ? (nM - fm) : WGM;
        u.pm = fm + ((wgid % nig) % gsz); u.pn = (wgid % nig) / gsz; return true;
    }
};
template <class C> DI int rowbase(int pm) { return C::rstride == 256 ? 256 * pm : (pm < 4 ? 256 * pm : 1024 + C::rstride * (pm - 4)); }

template <class Epi, bool ROWPERM, class C, int NSPLIT = 0>
DI void gemm_phase(LAS unsigned char* lds, const Gemm g, const Epi& E) {
    int tid_ = threadIdx.x; asm volatile("" : "+v"(tid_)); int bid_ = blockIdx.x; asm volatile("" : "+s"(bid_));
    const int tid = tid_, wid = __builtin_amdgcn_readfirstlane(tid >> 6), lane = tid & 63, wr = wid >> 2, wc = wid & 3, fr = lane & 15, fq = lane >> 4;
    constexpr int K = C::K, nt = K / BK;
    StaticOrder S; S.init(C::nM, C::nN, (int)gridDim.x, bid_);
    const bool split = NSPLIT > 0 && gridDim.x == 256;
    const int nfull = split ? (S.nwg / S.G) * S.G : S.nwg;
    const int nitems = nfull + (S.nwg - nfull) * (NSPLIT > 0 ? NSPLIT : 1);
    constexpr int NKP = NSPLIT > 0 ? nt / NSPLIT : nt;
    unsigned voffA[2], voffB[2];
#pragma unroll
    for (int i = 0; i < 2; ++i) { int R, Cc; stage_rc(tid * 16 + i * 8192, R, Cc); const int Rb = Epi::PERM ? ((R & ~31) + perm32(R & 31)) : R;
        const int Ra = ROWPERM ? (128 * (R >> 6) + 8 * (R & 15) + ((R >> 4) & 3)) : R;
        voffA[i] = (unsigned)(Ra * C::lda + Cc) * 2u; voffB[i] = (unsigned)(Rb * C::ldb + Cc) * 2u; }
    const size_t kstep = (size_t)(BK * 2);
    constexpr size_t hstepA = ROWPERM ? (size_t)4 * C::lda * 2 : (size_t)HALF * C::lda * 2;
    constexpr size_t hstepB = (size_t)HALF * C::ldb * 2;
    const unsigned ldsw = (unsigned)wid * 1024u;
    const int aoff = lds_byte(wr * 64 + fr, fq * 8), boff = lds_byte(wc * 32 + fr, fq * 8);
#define PG8_SA(b, h) (((b) * 2 + (h)) * HTB)
#define PG8_SB(b, h) ((4 + (b) * 2 + (h)) * HTB)
#define PG8_STAGE(bufoff, gbase, voff) do { _Pragma("unroll") for (int _i = 0; _i < 2; ++_i) \
        __builtin_amdgcn_global_load_lds((const unsigned*)((const char*)(gbase) + (voff)[_i]), (LAS unsigned*)(lds + (bufoff) + ldsw + _i * 8192), 16, 0, 0); } while (0)
#define PG8_LDA(dst, b, h) do { _Pragma("unroll") for (int m = 0; m < 4; ++m) _Pragma("unroll") for (int k = 0; k < 2; ++k) dst[m][k] = *(const LAS bf16x8*)(lds + PG8_SA(b, h) + aoff + m * 2048 + k * 1024); } while (0)
#define PG8_LDB(dst, b, h) do { _Pragma("unroll") for (int n = 0; n < 2; ++n) _Pragma("unroll") for (int k = 0; k < 2; ++k) dst[n][k] = *(const LAS bf16x8*)(lds + PG8_SB(b, h) + boff + n * 2048 + k * 1024); } while (0)
#define PG8_MMA(ai, bj, At, Bt) do { __builtin_amdgcn_s_setprio(1); _Pragma("unroll") for (int m = 0; m < 4; ++m) _Pragma("unroll") for (int n = 0; n < 2; ++n) _Pragma("unroll") for (int k = 0; k < 2; ++k) \
        acc[ai][bj][m][n] = __builtin_amdgcn_mfma_f32_16x16x32_bf16(Bt[n][k], At[m][k], acc[ai][bj][m][n], 0, 0, 0); __builtin_amdgcn_s_setprio(0); } while (0)
#define PG8_WAIT_V(n) asm volatile("s_waitcnt vmcnt(" #n ")" ::: "memory")
#define PG8_WAIT_L(n) asm volatile("s_waitcnt lgkmcnt(" #n ")" ::: "memory")
#define PG8_BAR __builtin_amdgcn_s_barrier()
#define PG8_SCHED __builtin_amdgcn_sched_barrier(0)
#define PG8_ABASE(u) ((const char*)g.A + ((size_t)rowbase<C>((u).pm) * C::lda + (C::acolmode ? 256 * ((u).pn >> 1) : 0)) * 2)
#define PG8_BBASE(u) ((const char*)g.Bt + (size_t)(u).pn * 256 * C::ldb * 2)
    Unit cur, nxt; int ui = 0; int curp = -1, curk = 0, nxtp = -1, nxtk = 0;
    if (!S.next_item(0, nfull, nitems, NSPLIT > 0 ? NSPLIT : 1, cur, curp, curk)) return;
    f32x4 acc[2][2][4][2];
#pragma unroll
    for (int a = 0; a < 2; ++a)
#pragma unroll
        for (int b = 0; b < 2; ++b)
#pragma unroll
            for (int m = 0; m < 4; ++m)
#pragma unroll
                for (int n = 0; n < 2; ++n) acc[a][b][m][n] = (f32x4){0.f, 0.f, 0.f, 0.f};
    bf16x8 At[4][2], B0[2][2], B1[2][2];
    const char* cA = PG8_ABASE(cur) + (size_t)(curp >= 0 ? curk * NKP : 0) * kstep; const char* cB = PG8_BBASE(cur) + (size_t)(curp >= 0 ? curk * NKP : 0) * kstep;
    PG8_STAGE(PG8_SB(0, 0), cB, voffB); PG8_STAGE(PG8_SA(0, 0), cA, voffA); PG8_STAGE(PG8_SB(0, 1), cB + hstepB, voffB); PG8_STAGE(PG8_SA(0, 1), cA + hstepA, voffA);
    if (wr == 1) PG8_BAR;
    PG8_WAIT_V(4); PG8_BAR;
    PG8_STAGE(PG8_SB(1, 0), cB + kstep, voffB); PG8_STAGE(PG8_SA(1, 0), cA + kstep, voffA); PG8_STAGE(PG8_SB(1, 1), cB + hstepB + kstep, voffB);
    PG8_WAIT_V(6); PG8_BAR;
    for (;;) {
        const bool has_next = S.next_item(ui + 1, nfull, nitems, NSPLIT > 0 ? NSPLIT : 1, nxt, nxtp, nxtk);
        const char* nA = has_next ? PG8_ABASE(nxt) + (size_t)(nxtp >= 0 ? nxtk * NKP : 0) * kstep : cA; const char* nB = has_next ? PG8_BBASE(nxt) + (size_t)(nxtp >= 0 ? nxtk * NKP : 0) * kstep : cB;
        const int nkt = (NSPLIT > 0 && curp >= 0) ? NKP : nt;
#pragma unroll 1
        for (int t = 0; t < nkt; t += 2) {
            const bool last = (t == nkt - 2);
            const char* a1 = cA + (size_t)(t + 1) * kstep;
            const char* a2 = last ? nA : cA + (size_t)(t + 2) * kstep; const char* b2 = last ? nB : cB + (size_t)(t + 2) * kstep;
            const char* a3 = a2 + kstep; const char* b3 = b2 + kstep;
            PG8_LDB(B0, 0, 0); PG8_SCHED; PG8_LDA(At, 0, 0); PG8_STAGE(PG8_SA(1, 1), a1 + hstepA, voffA);
            PG8_WAIT_L(8); PG8_BAR; PG8_WAIT_L(0); PG8_MMA(0, 0, At, B0); PG8_BAR; PG8_SCHED;
            PG8_LDB(B1, 0, 1); PG8_STAGE(PG8_SB(0, 0), b2, voffB);
            PG8_BAR; PG8_WAIT_L(0); PG8_MMA(0, 1, At, B1); PG8_BAR;
            PG8_LDA(At, 0, 1); PG8_STAGE(PG8_SA(0, 0), a2, voffA);
            PG8_BAR; PG8_WAIT_L(0); PG8_MMA(1, 0, At, B0); PG8_BAR; PG8_SCHED;
            PG8_STAGE(PG8_SB(0, 1), b2 + hstepB, voffB);
            PG8_WAIT_V(6); PG8_BAR; PG8_MMA(1, 1, At, B1); PG8_BAR;
            PG8_LDB(B0, 1, 0); PG8_SCHED; PG8_LDA(At, 1, 0); PG8_STAGE(PG8_SA(0, 1), a2 + hstepA, voffA);
            PG8_WAIT_L(8); PG8_BAR; PG8_WAIT_L(0); PG8_MMA(0, 0, At, B0); PG8_BAR; PG8_SCHED;
            PG8_LDB(B1, 1, 1); PG8_STAGE(PG8_SB(1, 0), b3, voffB);
            PG8_BAR; PG8_WAIT_L(0); PG8_MMA(0, 1, At, B1); PG8_BAR;
            PG8_LDA(At, 1, 1); PG8_STAGE(PG8_SA(1, 0), a3, voffA);
            PG8_BAR; PG8_WAIT_L(0); PG8_MMA(1, 0, At, B0); PG8_BAR; PG8_SCHED;
            PG8_STAGE(PG8_SB(1, 1), b3 + hstepB, voffB);
            PG8_WAIT_V(6); PG8_BAR; PG8_MMA(1, 1, At, B1); PG8_BAR;
        }
        if constexpr (NSPLIT > 0) { if (curp >= 0) E.store_piece(acc, curp, wr, wc, fr, fq); else E(acc, cur, rowbase<C>(cur.pm), wr, wc, fr, fq, lds + STAGE_BYTES); }
        else E(acc, cur, rowbase<C>(cur.pm), wr, wc, fr, fq, lds + STAGE_BYTES);
        if (!has_next) break;
#pragma unroll
        for (int a = 0; a < 2; ++a)
#pragma unroll
            for (int b = 0; b < 2; ++b)
#pragma unroll
                for (int m = 0; m < 4; ++m)
#pragma unroll
                    for (int n = 0; n < 2; ++n) acc[a][b][m][n] = (f32x4){0.f, 0.f, 0.f, 0.f};
        cur = nxt; curp = nxtp; curk = nxtk; cA = nA; cB = nB; ++ui;
    }
    PG8_WAIT_V(0);
    if (wr == 0) PG8_BAR;
    PG8_BAR;
#undef PG8_SA
#undef PG8_SB
#undef PG8_STAGE
#undef PG8_LDA
#undef PG8_LDB
#undef PG8_MMA
#undef PG8_WAIT_V
#undef PG8_WAIT_L
#undef PG8_BAR
#undef PG8_SCHED
#undef PG8_ABASE
#undef PG8_BBASE
}
}
using pg8::Unit;
typedef f32x4 AccT[2][2][4][2];

struct EpiStoreBf16 {
    static constexpr bool PERM = true;
    bf16_t* O; int ldc;
    DI void operator()(const AccT& acc, const Unit& u, int rb, int wr, int wc, int fr, int fq, LAS unsigned char*) const {
        const int row0 = rb + wr * 64 + fr, col0 = u.pn * 256 + wc * 32 + 8 * fq;
#pragma unroll
        for (int ai = 0; ai < 2; ++ai)
#pragma unroll
            for (int m = 0; m < 4; ++m) { bf16_t* rowp = O + (size_t)(row0 + ai * 128 + m * 16) * ldc + col0;
#pragma unroll
                for (int bj = 0; bj < 2; ++bj) { const f32x4 v0 = acc[ai][bj][m][0], v1 = acc[ai][bj][m][1];
                    u32x4 w; w.x = cvt_pk_bf16(v0[0], v0[1]); w.y = cvt_pk_bf16(v0[2], v0[3]); w.z = cvt_pk_bf16(v1[0], v1[1]); w.w = cvt_pk_bf16(v1[2], v1[3]);
                    *(u32x4*)(rowp + bj * 128) = w; } }
    }
};
struct EpiAddZ {
    static constexpr bool PERM = false;
    unsigned short* Z; bf16_t* PART; const bf16_t* H;
    DI void store_piece(const AccT& acc, int piece, int wr, int wc, int fr, int fq) const {
        bf16_t* base = PART + (size_t)piece * 65536 + (size_t)(wr * 64 + fr) * 256 + wc * 32 + 4 * fq;
#pragma unroll
        for (int ai = 0; ai < 2; ++ai)
#pragma unroll
            for (int m = 0; m < 4; ++m)
#pragma unroll
                for (int bj = 0; bj < 2; ++bj)
#pragma unroll
                    for (int n = 0; n < 2; ++n) { const f32x4 v = acc[ai][bj][m][n]; u32x2 o; o.x = cvt_pk_bf16(v[0], v[1]); o.y = cvt_pk_bf16(v[2], v[3]);
                        *(u32x2*)(base + (size_t)(ai * 128 + m * 16) * 256 + bj * 128 + n * 16) = o; }
    }
    DI void operator()(const AccT& acc, const Unit& u, int rb, int wr, int wc, int fr, int fq, LAS unsigned char*) const {
        const int row0 = rb + wr * 64 + fr, col0 = u.pn * 256 + wc * 32 + 4 * fq;
#pragma unroll
        for (int ai = 0; ai < 2; ++ai) {
            u32x2 hw[4][2][2];
#pragma unroll
            for (int m = 0; m < 4; ++m) { const bf16_t* rowp = H + (size_t)(row0 + ai * 128 + m * 16) * D + col0;
#pragma unroll
                for (int bj = 0; bj < 2; ++bj)
#pragma unroll
                    for (int n = 0; n < 2; ++n) hw[m][bj][n] = *(const u32x2*)(rowp + bj * 128 + n * 16); }
#pragma unroll
            for (int m = 0; m < 4; ++m) { unsigned short* rowp = Z + (size_t)(row0 + ai * 128 + m * 16) * D + col0;
#pragma unroll
                for (int bj = 0; bj < 2; ++bj)
#pragma unroll
                    for (int n = 0; n < 2; ++n) { const u32x2 w = hw[m][bj][n];
                        const f32x4 hv = (f32x4){__uint_as_float(w.x << 16), __uint_as_float(w.x & 0xffff0000u), __uint_as_float(w.y << 16), __uint_as_float(w.y & 0xffff0000u)};
                        const f32x4 zz = hv * ALPHA + acc[ai][bj][m][n]; u32x2 o; o.x = pk_half2(zz[0], zz[1]); o.y = pk_half2(zz[2], zz[3]);
                        *(u32x2*)(rowp + bj * 128 + n * 16) = o; } }
            asm volatile("" ::: "memory");
        }
    }
};
struct EpiGluRes {
    static constexpr bool PERM = false;
    unsigned short* Z; const bf16_t* H; bf16_t* PART;
    DI void store_piece(const AccT& acc, int piece, int wr, int wc, int fr, int fq) const {
        bf16_t* base = PART + (size_t)piece * 65536 + (size_t)(wr * 64 + fr) * 256 + wc * 32 + 4 * fq;
#pragma unroll
        for (int ai = 0; ai < 2; ++ai)
#pragma unroll
            for (int m = 0; m < 4; ++m)
#pragma unroll
                for (int bj = 0; bj < 2; ++bj)
#pragma unroll
                    for (int n = 0; n < 2; ++n) { const f32x4 v = acc[ai][bj][m][n]; u32x2 o; o.x = cvt_pk_bf16(v[0], v[1]); o.y = cvt_pk_bf16(v[2], v[3]);
                        *(u32x2*)(base + (size_t)(ai * 128 + m * 16) * 256 + bj * 128 + n * 16) = o; }
    }
    DI void operator()(const AccT& acc, const Unit& u, int rb, int wr, int wc, int fr, int fq, LAS unsigned char*) const {
        const int row0 = rb + wr * 64 + fr, col0 = u.pn * 128 + wc * 32 + 4 * fq;
#pragma unroll
        for (int ai = 0; ai < 2; ++ai) {
            u32x2 hw[4][2];
#pragma unroll
            for (int m = 0; m < 4; ++m) { const bf16_t* rowp = H + (size_t)(row0 + ai * 128 + m * 16) * D + col0;
#pragma unroll
                for (int n = 0; n < 2; ++n) hw[m][n] = *(const u32x2*)(rowp + n * 16); }
#pragma unroll
            for (int m = 0; m < 4; ++m) { unsigned short* rowp = Z + (size_t)(row0 + ai * 128 + m * 16) * D + col0;
#pragma unroll
                for (int n = 0; n < 2; ++n) { const f32x4 v = acc[ai][0][m][n], gt = acc[ai][1][m][n]; const u32x2 w = hw[m][n];
                    f32x4 zz = (f32x4){__uint_as_float(w.x << 16), __uint_as_float(w.x & 0xffff0000u), __uint_as_float(w.y << 16), __uint_as_float(w.y & 0xffff0000u)} * ALPHA;
#pragma unroll
                    for (int e = 0; e < 4; ++e) zz[e] += v[e] * sigmoid_f(gt[e]);
                    { u32x2 o; o.x = pk_half2(zz[0], zz[1]); o.y = pk_half2(zz[2], zz[3]); *(u32x2*)(rowp + n * 16) = o; } } }
            asm volatile("" ::: "memory");
        }
    }
};
struct EpiRgGates {
    static constexpr bool PERM = false;
    const bf16_t* XC; unsigned* AB; const float* bgate; const float* sp; const float* h0;
    DI void operator()(const AccT& acc, const Unit& u, int rb, int wr, int wc, int fr, int fq, LAS unsigned char*) const {
        const int row0 = rb + wr * 64 + fr;
        bool special = (rb < NSAMP) || (rb + 256 > MT);
        if (!special) { const int q0 = rb - NSAMP; const int b0 = (q0 + LP - 1) / LP; special = (b0 * LP < q0 + 256); }
#define RGG_ELEM(T0) \
                            const float r = __builtin_amdgcn_rcpf(1.0f + __builtin_amdgcn_exp2f(fmaf(ar[e], -1.4426950408889634f, brs[e]))); \
                            const float ig = __builtin_amdgcn_rcpf(1.0f + __builtin_amdgcn_exp2f(fmaf(aiv[e], -1.4426950408889634f, bis[e]))); \
                            float la2 = r * spl[e];                                     \
                            const float a = __builtin_amdgcn_exp2f(la2); \
                            const float mult = __builtin_amdgcn_sqrtf(fmaf(-a, a, 1.0f));     \
                            float bb = mult * (ig * xc[e]); \
                            if (T0) { bb += a * hz[e]; la2 = -__builtin_inff(); } \
                            o[e] = pk_half2(la2, bb);
#pragma unroll
        for (int n = 0; n < 2; ++n) {
            const int ch = u.pn * 128 + wc * 32 + 16 * n + 4 * fq;
            const f32x4 brs = ld4(bgate + ch) * -1.4426950408889634f, bis = ld4(bgate + D + ch) * -1.4426950408889634f, spl = ld4(sp + ch) * (-8.0f * 1.4426950408889634f);
            if (!special) {
                u32x2 xw[8];
#pragma unroll
                for (int k = 0; k < 8; ++k) xw[k] = *(const u32x2*)(XC + (size_t)(row0 + (k >> 2) * 128 + (k & 3) * 16) * D + ch);
#pragma unroll
                for (int k = 0; k < 8; ++k) {
                    const int ai = k >> 2, m = k & 3;
                    const float xc[4] = {__uint_as_float(xw[k].x << 16), __uint_as_float(xw[k].x & 0xffff0000u), __uint_as_float(xw[k].y << 16), __uint_as_float(xw[k].y & 0xffff0000u)};
                    const f32x4 ar = acc[ai][0][m][n], aiv = acc[ai][1][m][n]; const f32x4 hz = (f32x4){0.f, 0.f, 0.f, 0.f};
                    u32x4 o;
#pragma unroll
                    for (int e = 0; e < 4; ++e) { RGG_ELEM(false) }
                    *(u32x4*)(AB + (size_t)(row0 + ai * 128 + m * 16) * D + ch) = o;
                }
                asm volatile("" ::: "memory");
            } else {
#pragma unroll
                for (int ai = 0; ai < 2; ++ai)
#pragma unroll
                    for (int m = 0; m < 4; ++m) {
                        const int row = row0 + ai * 128 + m * 16;
                        if (row < MT) {
                            int t, b; bool pr;
                            if (row < NSAMP) { pr = false; b = row >> 3; t = row & 7; } else { pr = true; const int q = row - NSAMP; b = q / LP; t = q - b * LP; }
                            const u32x2 xw = *(const u32x2*)(XC + (size_t)row * D + ch);
                            const float xc[4] = {__uint_as_float(xw.x << 16), __uint_as_float(xw.x & 0xffff0000u), __uint_as_float(xw.y << 16), __uint_as_float(xw.y & 0xffff0000u)};
                            f32x4 hz = (f32x4){0.f, 0.f, 0.f, 0.f};
                            if (t == 0 && !pr) hz = ld4(h0 + (size_t)b * D + ch);
                            const f32x4 ar = acc[ai][0][m][n], aiv = acc[ai][1][m][n];
                            u32x4 o;
#pragma unroll
                            for (int e = 0; e < 4; ++e) { RGG_ELEM(t == 0) }
                            *(u32x4*)(AB + (size_t)row * D + ch) = o;
                        }
                        asm volatile("" ::: "memory");
                    }
            }
        }
#undef RGG_ELEM
    }
};

template <int KW>
DI void conv_prev(const AccT& acc, int bj, int n, bool samp, int wr, int wc, int fr, int fq, const LAS float* xch, const float* histp  , int histld, f32x4 (&xm)[KW - 1]) {
    if (samp) {
#pragma unroll
        for (int k = 1; k < KW; ++k) xm[k - 1] = ld4(histp + (size_t)(KW - 1 - k) * histld);
    } else {
#pragma unroll
        for (int k = 1; k < KW; ++k) { const int j = 8 - k; const f32x4 a = acc[j >> 2][bj][j & 3][n]; f32x4 v;
#pragma unroll
            for (int e = 0; e < 4; ++e) v[e] = __shfl_up(a[e], 1, 16);
            if (fr == 0) { if (wr == 1) v = *(const LAS f32x4*)(xch + (k - 1) * 256 + 128 * bj + 32 * wc + 16 * n + 4 * fq); else v = (f32x4){0.f, 0.f, 0.f, 0.f}; }
            xm[k - 1] = v; }
    }
}
template <int KW>
DI void xch_write(const AccT& acc, LAS float* xch, int wr, int wc, int fr, int fq) {
    if (wr == 0 && fr == 15) {
#pragma unroll
        for (int k = 1; k < KW; ++k) { const int j = 8 - k;
#pragma unroll
            for (int bj = 0; bj < 2; ++bj)
#pragma unroll
                for (int n = 0; n < 2; ++n) *(LAS f32x4*)(xch + (k - 1) * 256 + 128 * bj + 32 * wc + 16 * n + 4 * fq) = acc[j >> 2][bj][j & 3][n]; }
    }
    asm volatile("s_waitcnt lgkmcnt(0)" ::: "memory");
}
#define XROW(bj, n, i) acc[(i) >> 2][bj][(i) & 3][n]

struct EpiFfnUp {
    static constexpr bool PERM = true;
    int layer;
    DI void operator()(const AccT& acc, const Unit& u, int rb, int wr, int wc, int fr_, int fq_, LAS unsigned char* ldsx) const {
        asm volatile("" ::: "memory");
        int fr = fr_, fq = fq_; asm volatile("" : "+v"(fr), "+v"(fq));
        const KParams* kp = kparams();
        int ly = layer; asm volatile("" : "+s"(ly));
        bf16_t* ACT = (bf16_t*)(kp->ws + WS_ACT);
        const float* cw = kp->in[I_FCW] + (size_t)ly * 3 * FF2; const float* cb = kp->in[I_FCB] + (size_t)ly * FF2; const float* hist = kp->in[I_FFCONV] + (size_t)ly * 128 * 2 * FF2;
        float* out = kp->out;
        LAS float* xch = (LAS float*)ldsx;
        LAS unsigned char* wslice = ldsx + 4096 + (wr * 4 + wc) * 1024;
        {
            const int L_ = fq * 16 + fr, arr = L_ & 3, fq2 = (L_ >> 2) & 3, n2 = (L_ >> 4) & 1, bj2 = L_ >> 5;
            const int col = 128 * u.pn + 32 * wc + 8 * fq2 + 4 * n2 + bj2 * FF;
            const float* srcp = (arr < 3) ? (cw + (size_t)arr * FF2 + col) : (cb + col);
            *(LAS f32x4*)(wslice + L_ * 16) = ld4(srcp);
        }
        const bool samp = u.pm < 4;
        const int g0 = rb + 128 * wr + 8 * fr;
        if (!samp) xch_write<3>(acc, xch, wr, wc, fr, fq);
        int t0, bsq;
        if (samp) { bsq = g0 >> 3; t0 = 0; } else { const int q = g0 - NSAMP; bsq = q / LP; t0 = q - bsq * LP; }
        const int jmin = (u.pm > 4 && wr == 0 && fr == 0) ? 2 : 0;
        const int L = samp ? 8 : LP;
        const int offsel = samp ? ((int)O_FFCS + ly * 128 * 2 * FF2) : ((int)O_FFCP + ly * 8 * 2 * FF2);
        asm volatile("s_waitcnt vmcnt(0) lgkmcnt(0)" ::: "memory");
        const bool anym = __any((!samp) && (t0 < 2 || t0 + 7 >= LP));
        u32x2 ob[8];
#pragma unroll
        for (int n = 0; n < 2; ++n) {
            const int cv = 128 * u.pn + 32 * wc + 8 * fq + 4 * n;
            f32x4 vm[2], gm[2];
            const float* hp = hist + (size_t)bsq * 2 * FF2 + cv;
            conv_prev<3>(acc, 0, n, samp, wr, wc, fr, fq, xch, hp, FF2, vm);
            conv_prev<3>(acc, 1, n, samp, wr, wc, fr, fq, xch, hp + FF, FF2, gm);
            const LAS f32x4* wsl = (const LAS f32x4*)wslice + (n * 4 + fq) * 4;
            const f32x4 wv0 = wsl[0], wv1 = wsl[1], wv2 = wsl[2], bv = wsl[3];
            const f32x4 wg0 = wsl[32], wg1 = wsl[33], wg2 = wsl[34], bg = wsl[35];
#define FFN_ROWS(MASK) _Pragma("unroll") \
            for (int j = 0; j < 8; ++j) { \
                int tj = t0 + j, bq = bsq; if (!samp && tj >= LP) { tj -= LP; bq++; } \
                const f32x4 z4 = (f32x4){0.f, 0.f, 0.f, 0.f}; \
                const f32x4 v0 = XROW(0, n, j), g0v = XROW(1, n, j); \
                f32x4 v1 = (j >= 1) ? XROW(0, n, (j >= 1 ? j - 1 : 0)) : vm[0], g1 = (j >= 1) ? XROW(1, n, (j >= 1 ? j - 1 : 0)) : gm[0]; \
                f32x4 v2 = (j >= 2) ? XROW(0, n, (j >= 2 ? j - 2 : 0)) : vm[j >= 2 ? 0 : 1 - j], g2 = (j >= 2) ? XROW(1, n, (j >= 2 ? j - 2 : 0)) : gm[j >= 2 ? 0 : 1 - j]; \
                if (MASK) { if (tj < 1) { v1 = z4; g1 = z4; } if (tj < 2) { v2 = z4; g2 = z4; } } \
                const f32x4 V = bv + wv2 * v0 + wv1 * v1 + wv0 * v2; \
                const f32x4 G = bg + wg2 * g0v + wg1 * g1 + wg0 * g2; \
                if (j >= jmin) { \
                    const int grow = g0 + j; \
                    const f32x4 A = G * (G * G * (-2.3022081989f * 0.044715f) + (-2.3022081989f)); \
                    f32x4 E; E[0] = __builtin_amdgcn_exp2f(A[0]); E[1] = __builtin_amdgcn_exp2f(A[1]); E[2] = __builtin_amdgcn_exp2f(A[2]); E[3] = __builtin_amdgcn_exp2f(A[3]); \
                    const f32x4 Dn = E + 1.0f; \
                    f32x4 R; R[0] = __builtin_amdgcn_rcpf(Dn[0]); R[1] = __builtin_amdgcn_rcpf(Dn[1]); R[2] = __builtin_amdgcn_rcpf(Dn[2]); R[3] = __builtin_amdgcn_rcpf(Dn[3]); \
                    const f32x4 O = (G * V) * R; \
                    u32x2 o; o.x = cvt_pk_bf16(O[0], O[1]); o.y = cvt_pk_bf16(O[2], O[3]); \
                    if (n == 0) ob[j] = o; else { u32x4 w4; w4.x = ob[j].x; w4.y = ob[j].y; w4.z = o.x; w4.w = o.y; *(u32x4*)(ACT + (size_t)grow * FF + (cv - 4)) = w4; } \
                    if (tj >= L - 2) { float* op = out + (size_t)(offsel + (bq * 2 + (tj - (L - 2))) * FF2 + cv); st4(op, v0); st4(op + FF, g0v); } \
                } \
                asm volatile("" ::: "memory"); \
            }
            if (anym) { FFN_ROWS(true) } else { FFN_ROWS(false) }
#undef FFN_ROWS
        }
    }
};
struct EpiRgIn {
    static constexpr bool PERM = false;
    int layer;
    DI void operator()(const AccT& acc, const Unit& u, int rb, int wr, int wc, int fr_, int fq_, LAS unsigned char* ldsx) const {
        asm volatile("" ::: "memory");
        int fr = fr_, fq = fq_; asm volatile("" : "+v"(fr), "+v"(fq));
        const KParams* kp = kparams();
        int ly = layer; asm volatile("" : "+s"(ly));
        bf16_t* GATE = (bf16_t*)(kp->ws + WS_GATE); bf16_t* XC = (bf16_t*)(kp->ws + WS_XC);
        const float* cw = kp->in[I_RGCW] + (size_t)ly * 4 * D; const float* cb = kp->in[I_RGCB] + (size_t)ly * D; const float* hist = kp->in[I_RGCONV] + (size_t)ly * 128 * 3 * D;
        float* out = kp->out; const int offP = (int)O_RGCP + ly * 8 * 3 * D, offS = (int)O_RGCS + ly * 128 * 3 * D;
        LAS float* xch = (LAS float*)ldsx;
        const bool samp = u.pm < 4;
        const int g0 = rb + 128 * wr + 8 * fr;
        const int jmin = (u.pm > 4 && wr == 0 && fr == 0) ? 3 : 0;
        if (u.pn < 4) {
#pragma unroll
            for (int bj = 0; bj < 2; ++bj)
#pragma unroll
                for (int n = 0; n < 2; ++n) { const int c = 256 * u.pn + 128 * bj + 32 * wc + 16 * n + 4 * fq;
#pragma unroll
                    for (int j = 0; j < 8; ++j) { const int grow = g0 + j;
                        if (j >= jmin && grow < MT) { const f32x4 v = XROW(bj, n, j); u32x2 o; o.x = cvt_pk_bf16(gelu_f(v[0]), gelu_f(v[1])); o.y = cvt_pk_bf16(gelu_f(v[2]), gelu_f(v[3]));
                            *(u32x2*)(GATE + (size_t)grow * D + c) = o; }
                        asm volatile("" ::: "memory"); } }
            return;
        }
        LAS unsigned char* wslice = ldsx + 4096 + (wr * 4 + wc) * 1280;
        {
            const int lane_ = fq * 16 + fr;
#pragma unroll
            for (int rep2 = 0; rep2 < 2; ++rep2) { const int sl = lane_ + 64 * rep2;
                if (sl < 80) { const int arr = sl % 5, tq = sl / 5, fq2 = tq & 3, n2 = (tq >> 2) & 1, bj2 = tq >> 3;
                    const int chs = 256 * (u.pn - 4) + 128 * bj2 + 32 * wc + 16 * n2 + 4 * fq2;
                    const float* srcp = (arr < 4) ? (cw + (size_t)arr * D + chs) : (cb + chs);
                    *(LAS f32x4*)(wslice + sl * 16) = ld4(srcp); } }
        }
        if (!samp) xch_write<4>(acc, xch, wr, wc, fr, fq);
        int t0, bsq;
        if (samp) { bsq = g0 >> 3; t0 = 0; } else { const int q = g0 - NSAMP; bsq = q / LP; t0 = q - bsq * LP; }
        const int L = samp ? 8 : LP;
        const int smask = -(int)samp; const int offsel = (offS & smask) | (offP & ~smask);
        asm volatile("s_waitcnt vmcnt(0) lgkmcnt(0)" ::: "memory");
        const bool anym = __any((!samp) && (t0 < 3 || t0 + 7 >= LP));
#pragma unroll
        for (int bj = 0; bj < 2; ++bj)
#pragma unroll
            for (int n = 0; n < 2; ++n) {
                const int ch = 256 * (u.pn - 4) + 128 * bj + 32 * wc + 16 * n + 4 * fq;
                f32x4 xm[3];
                conv_prev<4>(acc, bj, n, samp, wr, wc, fr, fq, xch, hist + (size_t)bsq * 3 * D + ch, D, xm);
                const LAS f32x4* wsl = (const LAS f32x4*)wslice + ((bj * 2 + n) * 4 + fq) * 5;
                const f32x4 w0 = wsl[0], w1 = wsl[1], w2 = wsl[2], w3 = wsl[3], bv = wsl[4];
#define RGIN_ROWS(MASK) _Pragma("unroll") \
                for (int j = 0; j < 8; ++j) { \
                    int tj = t0 + j, bq = bsq; if (!samp && tj >= LP) { tj -= LP; bq++; } \
                    const f32x4 z4 = (f32x4){0.f, 0.f, 0.f, 0.f}; \
                    const f32x4 x0 = XROW(bj, n, j); \
                    f32x4 x1 = (j >= 1) ? XROW(bj, n, (j >= 1 ? j - 1 : 0)) : xm[0]; \
                    f32x4 x2 = (j >= 2) ? XROW(bj, n, (j >= 2 ? j - 2 : 0)) : xm[j >= 2 ? 0 : 1 - j]; \
                    f32x4 x3 = (j >= 3) ? XROW(bj, n, (j >= 3 ? j - 3 : 0)) : xm[j >= 3 ? 0 : 2 - j]; \
                    if (MASK) { if (tj < 1) x1 = z4; if (tj < 2) x2 = z4; if (tj < 3) x3 = z4; } \
                    const f32x4 y = bv + w3 * x0 + w2 * x1 + w1 * x2 + w0 * x3; \
                    const int grow = g0 + j; \
                    if (j >= jmin && grow < MT) { \
                        u32x2 o; o.x = cvt_pk_bf16(y[0], y[1]); o.y = cvt_pk_bf16(y[2], y[3]); \
                        *(u32x2*)(XC + (size_t)grow * D + ch) = o; \
                        if (tj >= L - 3) st4(out + (size_t)(offsel + (bq * 3 + (tj - (L - 3))) * D + ch), x0); \
                    } \
                    asm volatile("" ::: "memory"); \
                }
                if (anym) { RGIN_ROWS(true) } else { RGIN_ROWS(false) }
#undef RGIN_ROWS
            }
    }
};

struct CvtJob { const float* src; bf16_t* dst; int K, Nsrc, Nt, Hn; };
DI void cvt_tile(const CvtJob& jb, int tile, LAS float* tl) {
    const int tid = opaque_tid();
    const int nkt = jb.K / 64; const int rt = tile / nkt, kt = tile - rt * nkt;
    const int r0 = rt * 256, k0 = kt * 64;
    int scA = r0, scB = r0 + 128;
    if (jb.Hn) { const int pn = r0 >> 8; scA = 128 * pn; scB = jb.Hn + 128 * pn; }
    { const int ty = tid >> 6, tx = tid & 63; float v[8][4];
#pragma unroll
      for (int i = 0; i < 8; ++i) { const float* sp = jb.src + (size_t)(k0 + ty + 8 * i) * jb.Nsrc;
          v[i][0] = sp[scA + tx]; v[i][1] = sp[scA + 64 + tx]; v[i][2] = sp[scB + tx]; v[i][3] = sp[scB + 64 + tx]; }
#pragma unroll
      for (int i = 0; i < 8; ++i) { const int kk = ty + 8 * i;
#pragma unroll
          for (int c = 0; c < 4; ++c) tl[kk * 257 + tx + 64 * c] = v[i][c]; } }
    __syncthreads();
    { const int i = tid >> 1, kh = tid & 1;
#pragma unroll
      for (int q = 0; q < 4; ++q) { float v[8];
#pragma unroll
          for (int e = 0; e < 8; ++e) v[e] = tl[(32 * kh + 8 * q + e) * 257 + i];
          u32x4 w; w.x = cvt_pk_bf16(v[0], v[1]); w.y = cvt_pk_bf16(v[2], v[3]); w.z = cvt_pk_bf16(v[4], v[5]); w.w = cvt_pk_bf16(v[6], v[7]);
          *(u32x4*)(jb.dst + (size_t)(r0 + i) * jb.K + k0 + 32 * kh + 8 * q) = w; } }
    __syncthreads();
}
DI void cvt_job(const float* src, bf16_t* dst, int K, int Nsrc, int Nt, int Hn, int& base, LAS float* tl, int vb, int G) {
    CvtJob jb{src, dst, K, Nsrc, Nt, Hn};
    const int ntile = (K / 64) * (Nt / 256);
    int first = (vb - base) % G; if (first < 0) first += G;
    for (int t = first; t < ntile; t += G) cvt_tile(jb, t, tl);
    base = (base + ntile) % G;
}
DI void cvt_first(const Params& p, LAS unsigned char* lds, int vb, int VG) {
    LAS float* tl = (LAS float*)lds; int base = 0;
    cvt_job(p.in[I_S5WIN], (bf16_t*)(p.ws + WS_W_S5IN), 1024, 1024, 1024, 0, base, tl, vb, VG);
}
DI void cvt_rest(const Params& p, LAS unsigned char* lds, int vb, int VG) {
    unsigned char* ws = p.ws;
    LAS float* tl = (LAS float*)lds;
    int base = 0;
    cvt_job(p.in[I_S5WOUT], (bf16_t*)(ws + WS_W_S5OUT), 1024, 2048, 2048, 1024, base, tl, vb, VG);
#pragma unroll 1
    for (int i = 0; i < 4; ++i) {
        cvt_job(p.in[I_WUP] + (size_t)i * 1024 * FF2, (bf16_t*)(ws + WS_W_UP) + (size_t)i * FF2 * 1024, 1024, FF2, FF2, FF, base, tl, vb, VG);
        cvt_job(p.in[I_WDN] + (size_t)i * FF * 1024, (bf16_t*)(ws + WS_W_DN) + (size_t)i * 1024 * FF, FF, 1024, 1024, 0, base, tl, vb, VG);
    }
#pragma unroll 1
    for (int j = 0; j < 2; ++j) {
        if (j == 1) {
            cvt_job(p.in[I_S5WIN] + (size_t)j * 1024 * 1024, (bf16_t*)(ws + WS_W_S5IN) + (size_t)j * 1024 * 1024, 1024, 1024, 1024, 0, base, tl, vb, VG);
            cvt_job(p.in[I_S5WOUT] + (size_t)j * 1024 * 2048, (bf16_t*)(ws + WS_W_S5OUT) + (size_t)j * 2048 * 1024, 1024, 2048, 2048, 1024, base, tl, vb, VG);
        }
        cvt_job(p.in[I_RGWIN] + (size_t)j * 1024 * 2048, (bf16_t*)(ws + WS_W_RGIN) + (size_t)j * 2048 * 1024, 1024, 2048, 2048, 0, base, tl, vb, VG);
        for (int nb = 0; nb < 4; ++nb)
            cvt_job(p.in[I_RGWG] + (size_t)(j * 4 + nb) * 256 * 512, (bf16_t*)(ws + WS_W_RGG) + (size_t)(j * 4 + nb) * 512 * 256, 256, 512, 512, 256, base, tl, vb, VG);
        cvt_job(p.in[I_RGWOUT] + (size_t)j * 1024 * 1024, (bf16_t*)(ws + WS_W_RGOUT) + (size_t)j * 1024 * 1024, 1024, 1024, 1024, 0, base, tl, vb, VG);
    }
}
DI void p0_phase(const Params& p, LAS unsigned char* lds) {
    unsigned char* ws = p.ws;
    cvt_first(p, lds, opaque_bid(), (int)gridDim.x);
    if (gridDim.x != 256) cvt_rest(p, lds, opaque_bid(), (int)gridDim.x);
    {
        const int tid = opaque_tid(); const int lane = tid & 63, gw = opaque_bid() * 8 + (tid >> 6), NGW = (int)gridDim.x * 8;
        bf16_t* H = (bf16_t*)(ws + WS_H);
        for (int row = gw; row < MA; row += NGW) {
            const float* src = nullptr;
            if (row < NSAMP) src = p.in[I_XS] + (size_t)row * D;
            else if (row < MT) { const int q = row - NSAMP, b = q / LP, t = q - b * LP; src = t < 16 ? p.in[I_META] + (size_t)t * D : p.in[I_XP] + ((size_t)b * 2048 + (t - 16)) * D; }
#pragma unroll
            for (int i = 0; i < 4; ++i) { const int c = 4 * lane + 256 * i; f32x4 v = (f32x4){0.f, 0.f, 0.f, 0.f}; if (src) v = ld4(src + c);
                u32x2 o; o.x = cvt_pk_bf16(v[0], v[1]); o.y = cvt_pk_bf16(v[2], v[3]); *(u32x2*)(H + (size_t)row * D + c) = o; }
        }
    }
    {
        const int gt = opaque_bid() * 512 + opaque_tid(), NT = (int)gridDim.x * 512;
        float* AB = (float*)(ws + WS_S5AB); bf16_t* BB = (bf16_t*)(ws + WS_S5BB); bf16_t* CC = (bf16_t*)(ws + WS_S5CC); float* SP = (float*)(ws + WS_RGSP);
        for (int it = gt; it < 2 * 64 * 64; it += NT) {
            const int pp = it & 63, g = (it >> 6) & 63, j = it >> 12; const int jg = j * 64 + g;
            const float step = expf(p.in[I_LOGSTEP][jg]); const float lr = p.in[I_LAMRE][jg * 64 + pp], li = p.in[I_LAMIM][jg * 64 + pp];
            const float mag = expf(lr * step); const float abr = mag * cosf(li * step), abi = mag * sinf(li * step);
            const float den = lr * lr + li * li, nr = abr - 1.0f, ni = abi;
            const float qr = (nr * lr + ni * li) / den, qi = (ni * lr - nr * li) / den;
            AB[(jg * 64 + pp) * 2] = abr; AB[(jg * 64 + pp) * 2 + 1] = abi;
            for (int h = 0; h < 16; ++h) {
                const float br = p.in[I_BRE][(size_t)(jg * 64 + pp) * 16 + h], bi = p.in[I_BIM][(size_t)(jg * 64 + pp) * 16 + h];
                BB[((size_t)(jg * 2 + 0) * 64 + pp) * 16 + h] = (bf16_t)(cvt_pk_bf16(qr * br - qi * bi, 0.f) & 0xffffu);
                BB[((size_t)(jg * 2 + 1) * 64 + pp) * 16 + h] = (bf16_t)(cvt_pk_bf16(qr * bi + qi * br, 0.f) & 0xffffu);
                const float cr = p.in[I_CRE][(size_t)(jg * 16 + h) * 64 + pp], ci = p.in[I_CIM][(size_t)(jg * 16 + h) * 64 + pp];
                *(unsigned*)(CC + (size_t)(jg * 16 + h) * 128 + 2 * pp) = cvt_pk_bf16(cr, -ci);
            }
        }
        for (int it = gt; it < 2 * 1024; it += NT) SP[it] = log1pf(expf(-p.in[I_RGLAM][it]));
        { pg8::StaticOrder S; S.init(69, 4, (int)gridDim.x, 0); const int nfull = (gridDim.x == 256) ? (S.nwg / S.G) * S.G : S.nwg; int* tmap = (int*)(ws + WS_TMAP);
          for (int L = gt; L < S.nwg; L += NT) { pg8::Unit u; S.unit(L, u); tmap[u.pm * 4 + u.pn] = (L >= nfull) ? (L - nfull) : -1; } }
    }
}

DI void ln_phase(const Params& p, int idx, bool fin, bool dry, int nsplit, const bf16_t* part, bool glu) {
    const int tid = opaque_tid(); const int lane = tid & 63, gw = opaque_bid() * 8 + (tid >> 6), NGW = (int)gridDim.x * 8;
    bf16_t* H = (bf16_t*)(p.ws + WS_H); const unsigned short* Z = (const unsigned short*)(p.ws + WS_Z);
    const float* gam = p.in[I_LNG] + (size_t)idx * D; const float* bet = p.in[I_LNB] + (size_t)idx * D;
    f32x4 gg[4], bb[4];
#pragma unroll
    for (int i = 0; i < 4; ++i) { gg[i] = ld4(gam + 4 * lane + 256 * i); bb[i] = ld4(bet + 4 * lane + 256 * i); }
    for (int rowa = gw; rowa < MT; rowa += 2 * NGW) {
        const int rowb = rowa + NGW; const bool hasb = rowb < MT;
        f32x4 vv[2][4];
#pragma unroll
        for (int i = 0; i < 4; ++i) { const u32x2 wa = *(const u32x2*)(Z + (size_t)rowa * D + 4 * lane + 256 * i); u32x2 wb; wb.x = 0u; wb.y = 0u; if (hasb) wb = *(const u32x2*)(Z + (size_t)rowb * D + 4 * lane + 256 * i);
            vv[0][i] = (f32x4){half_lo(wa.x), half_hi(wa.x), half_lo(wa.y), half_hi(wa.y)}; vv[1][i] = (f32x4){half_lo(wb.x), half_hi(wb.x), half_lo(wb.y), half_hi(wb.y)}; }
        if (nsplit && glu && gridDim.x == 256) {
#pragma unroll
            for (int rr = 0; rr < 2; ++rr) { const int row = rr ? rowb : rowa; if (rr == 1 && !hasb) break;
                if (row >= 64 * 256) {
                    u32x2 hw4[4];
#pragma unroll
                    for (int i = 0; i < 4; ++i) hw4[i] = *(const u32x2*)(H + (size_t)row * D + 4 * lane + 256 * i);
                    f32x4 sv[4], sg[4];
#pragma unroll
                    for (int i = 0; i < 4; ++i) { sv[i] = (f32x4){0.f, 0.f, 0.f, 0.f}; sg[i] = (f32x4){0.f, 0.f, 0.f, 0.f}; }
                    const int tb = ((row >> 8) - 64) * 8 + (lane >> 5), cc = (4 * lane) & 127;
                    for (int k = 0; k < nsplit; ++k) { u32x2 wv[4], wg[4];
#pragma unroll
                        for (int i = 0; i < 4; ++i) { const bf16_t* pp = part + ((size_t)((tb + 2 * i) * nsplit + k) * 256 + (row & 255)) * 256 + cc; wv[i] = *(const u32x2*)pp; wg[i] = *(const u32x2*)(pp + 128); }
#pragma unroll
                        for (int i = 0; i < 4; ++i) {
                            sv[i][0] += __uint_as_float(wv[i].x << 16); sv[i][1] += __uint_as_float(wv[i].x & 0xffff0000u); sv[i][2] += __uint_as_float(wv[i].y << 16); sv[i][3] += __uint_as_float(wv[i].y & 0xffff0000u);
                            sg[i][0] += __uint_as_float(wg[i].x << 16); sg[i][1] += __uint_as_float(wg[i].x & 0xffff0000u); sg[i][2] += __uint_as_float(wg[i].y << 16); sg[i][3] += __uint_as_float(wg[i].y & 0xffff0000u); } }
#pragma unroll
                    for (int i = 0; i < 4; ++i) { const f32x4 hb = (f32x4){__uint_as_float(hw4[i].x << 16), __uint_as_float(hw4[i].x & 0xffff0000u), __uint_as_float(hw4[i].y << 16), __uint_as_float(hw4[i].y & 0xffff0000u)} * ALPHA;
#pragma unroll
                        for (int e = 0; e < 4; ++e) vv[rr][i][e] = hb[e] + sv[i][e] * sigmoid_f(sg[i][e]); }
                }
            }
        } else if (nsplit && gridDim.x == 256) {
#pragma unroll
            for (int rr = 0; rr < 2; ++rr) { const int row = rr ? rowb : rowa; if (rr == 1 && !hasb) break;
                if (row >= 64 * 256) {
                    u32x2 hw4[4];
#pragma unroll
                    for (int i = 0; i < 4; ++i) hw4[i] = *(const u32x2*)(H + (size_t)row * D + 4 * lane + 256 * i);
#pragma unroll
                    for (int i = 0; i < 4; ++i) vv[rr][i] = (f32x4){__uint_as_float(hw4[i].x << 16), __uint_as_float(hw4[i].x & 0xffff0000u), __uint_as_float(hw4[i].y << 16), __uint_as_float(hw4[i].y & 0xffff0000u)} * ALPHA;
                    const int tb = ((row >> 8) - 64) * 4;
                    for (int k = 0; k < nsplit; ++k) { u32x2 w4[4];
#pragma unroll
                        for (int i = 0; i < 4; ++i) w4[i] = *(const u32x2*)(part + ((size_t)((tb + i) * nsplit + k) * 256 + (row & 255)) * 256 + 4 * lane);
#pragma unroll
                        for (int i = 0; i < 4; ++i) { vv[rr][i][0] += __uint_as_float(w4[i].x << 16); vv[rr][i][1] += __uint_as_float(w4[i].x & 0xffff0000u); vv[rr][i][2] += __uint_as_float(w4[i].y << 16); vv[rr][i][3] += __uint_as_float(w4[i].y & 0xffff0000u); } }
                }
            }
        }
#pragma unroll
        for (int rr = 0; rr < 2; ++rr) {
            if (rr == 1 && !hasb) break;
            const int row = rr ? rowb : rowa;
            float s = 0.f;
#pragma unroll
            for (int i = 0; i < 4; ++i) s += (vv[rr][i][0] + vv[rr][i][1]) + (vv[rr][i][2] + vv[rr][i][3]);
#pragma unroll
            for (int o = 32; o >= 1; o >>= 1) s += __shfl_xor(s, o);
            const float mu = s * (1.0f / 1024.0f); float q = 0.f;
#pragma unroll
            for (int i = 0; i < 4; ++i) { const f32x4 d = vv[rr][i] - mu; q += (d[0] * d[0] + d[1] * d[1]) + (d[2] * d[2] + d[3] * d[3]); }
#pragma unroll
            for (int o = 32; o >= 1; o >>= 1) q += __shfl_xor(q, o);
            const float rstd = 1.0f / sqrtf(q * (1.0f / 1024.0f) + LN_EPS);
            float* orow = nullptr;
            if (fin) { if (row < NSAMP) orow = p.out + O_YS + (size_t)row * D; else { const int qq = row - NSAMP, b = qq / LP, t = qq - b * LP; if (t >= 16) orow = p.out + O_YP + ((size_t)b * 2048 + (t - 16)) * D; } }
#pragma unroll
            for (int i = 0; i < 4; ++i) { const int c = 4 * lane + 256 * i; const f32x4 hn = (vv[rr][i] - mu) * rstd * gg[i] + bb[i];
                if (!fin) { u32x2 o; o.x = cvt_pk_bf16(hn[0], hn[1]); o.y = cvt_pk_bf16(hn[2], hn[3]); *(u32x2*)(H + (size_t)row * D + c) = o; }
                else if (orow) st4(orow + c, hn); }
        }
    }
}

DI void s5_phase(const Params& p, int j, LAS unsigned char* lds, int task0, int slot, int nslots) {
    const int tid = opaque_tid(), lane = tid & 63, wave = __builtin_amdgcn_readfirstlane(tid >> 6), r = lane & 31, hh = lane >> 5, c16 = lane & 15, q16 = lane >> 4;
    LAS unsigned char* img = lds + wave * 8704;
    const bf16_t* U = (const bf16_t*)(p.ws + WS_U); bf16_t* GY = (bf16_t*)(p.ws + WS_GY);
    const float* ABall = (const float*)(p.ws + WS_S5AB); const bf16_t* BBall = (const bf16_t*)(p.ws + WS_S5BB); const bf16_t* CCall = (const bf16_t*)(p.ws + WS_S5CC);
    const int tau = 16 * ((r >> 2) & 1) + 4 * (r >> 3) + (r & 3);
    for (int task = task0 + slot; task < 512 + 8192; task += nslots) {
        const bool pr = task < 512; int seq, g, L, row0;
        if (pr) { seq = task >> 6; g = task & 63; L = LP; row0 = NSAMP + seq * LP; } else { const int q = task - 512; seq = q >> 6; g = q & 63; L = 8; row0 = seq * 8; }
        const int jg = j * 64 + g;
        bf16x8 bfr[2][2];
#pragma unroll
        for (int s = 0; s < 2; ++s)
#pragma unroll
            for (int ri = 0; ri < 2; ++ri) bfr[s][ri] = *(const bf16x8*)(BBall + ((size_t)(jg * 2 + ri) * 64 + 32 * s + r) * 16 + 8 * hh);
        float ar[2], ai[2], cr[2], ci[2], fre[2] = {0.f, 0.f}, fim[2] = {0.f, 0.f};
#pragma unroll
        for (int s = 0; s < 2; ++s) { ar[s] = ABall[(jg * 64 + 32 * s + r) * 2]; ai[s] = ABall[(jg * 64 + 32 * s + r) * 2 + 1];
            if (pr) { cr[s] = 0.f; ci[s] = 0.f; } else { const size_t o = ((size_t)(j * 128 + seq) * 64 + g) * 64 + 32 * s + r; cr[s] = p.in[I_S5RE][o]; ci[s] = p.in[I_S5IM][o]; } }
        bf16x8 cfr[4];
#pragma unroll
        for (int ks = 0; ks < 4; ++ks) cfr[ks] = *(const bf16x8*)(CCall + (size_t)(jg * 16 + c16) * 128 + 32 * ks + 8 * q16);
        const float dsk = p.in[I_S5D][j * 1024 + 16 * g + c16];
        const int nch = (L + 31) >> 5;
        const bf16_t* ufp = U + (size_t)(row0 + tau) * D + 16 * g + 8 * hh;
        const bf16_t* usp = U + (size_t)(row0 + 4 * q16) * D + 16 * g + c16;
        bf16x8 uf_n = *(const bf16x8*)ufp; bf16_t us_n[8];
#pragma unroll
        for (int e = 0; e < 8; ++e) us_n[e] = usp[(size_t)(16 * (e >> 2) + (e & 3)) * D];
        for (int c = 0; c < nch; ++c) {
            const int t0 = 32 * c;
            const bf16x8 uf = uf_n; bf16_t us[8];
#pragma unroll
            for (int e = 0; e < 8; ++e) us[e] = us_n[e];
            if (c + 1 < nch) {
                uf_n = *(const bf16x8*)(ufp + (size_t)(t0 + 32) * D);
#pragma unroll
                for (int e = 0; e < 8; ++e) us_n[e] = usp[(size_t)(t0 + 32 + 16 * (e >> 2) + (e & 3)) * D];
            }
            f32x16 X[2][2];
#pragma unroll
            for (int s = 0; s < 2; ++s)
#pragma unroll
                for (int ri = 0; ri < 2; ++ri) { f32x16 z;
#pragma unroll
                    for (int i = 0; i < 16; ++i) z[i] = 0.f;
                    X[s][ri] = __builtin_amdgcn_mfma_f32_32x32x16_bf16(uf, bfr[s][ri], z, 0, 0, 0); }
#pragma unroll
            for (int s = 0; s < 2; ++s) {
                float sr = hh ? 0.f : cr[s], si = hh ? 0.f : ci[s];
#pragma unroll
                for (int i = 0; i < 16; ++i) {
                    float nr = fmaf(ar[s], sr, X[s][0][i]); nr = fmaf(-ai[s], si, nr);
                    float ni = fmaf(ar[s], si, X[s][1][i]); ni = fmaf(ai[s], sr, ni);
                    sr = nr; si = ni; X[s][0][i] = sr; X[s][1][i] = si;
                }
                if (c == nch - 1) { fre[s] = pr ? X[s][0][15] : X[s][0][7]; fim[s] = pr ? X[s][1][15] : X[s][1][7]; }
                const float er = __shfl(X[s][0][15], r), ei = __shfl(X[s][1][15], r);
                float xr = hh ? er : 0.f, xi = hh ? ei : 0.f;
#pragma unroll
                for (int i = 0; i < 16; ++i) {
                    const float tr = ar[s] * xr - ai[s] * xi, ti = ar[s] * xi + ai[s] * xr; xr = tr; xi = ti;
                    X[s][0][i] += xr; X[s][1][i] += xi;
                }
                cr[s] = __shfl(X[s][0][15], 32 + r); ci[s] = __shfl(X[s][1][15], 32 + r);
#pragma unroll
                for (int i = 0; i < 16; ++i) *(LAS unsigned*)(img + (16 * hh + i) * 272 + 4 * (32 * s + r)) = cvt_pk_bf16(X[s][0][i], X[s][1][i]);
            }
            asm volatile("s_waitcnt lgkmcnt(0)" ::: "memory");
            f32x4 Dm[2] = {(f32x4){0.f, 0.f, 0.f, 0.f}, (f32x4){0.f, 0.f, 0.f, 0.f}};
#pragma unroll
            for (int mb = 0; mb < 2; ++mb)
#pragma unroll
                for (int ks = 0; ks < 4; ++ks) { const bf16x8 a = *(const LAS bf16x8*)(img + (16 * mb + c16) * 272 + (32 * ks + 8 * q16) * 2);
                    Dm[mb] = __builtin_amdgcn_mfma_f32_16x16x32_bf16(a, cfr[ks], Dm[mb], 0, 0, 0); }
#pragma unroll
            for (int mb = 0; mb < 2; ++mb)
#pragma unroll
                for (int rg = 0; rg < 4; ++rg) { const int t = t0 + 16 * mb + 4 * q16 + rg;
                    if (t < L) { const size_t off = (size_t)(row0 + t) * D + 16 * g + c16; const float y = Dm[mb][rg] + dsk * bf2f(us[4 * mb + rg]); GY[off] = (bf16_t)(cvt_pk_bf16(gelu_f(y), 0.f) & 0xffffu); } }
            asm volatile("s_waitcnt lgkmcnt(0)" ::: "memory");
        }
        if (hh == 0) {
            float* ore = p.out + (pr ? O_S5RP : O_S5RS); float* oim = p.out + (pr ? O_S5IP : O_S5IS);
            const size_t o = ((size_t)(j * (pr ? 8 : 128) + seq) * 64 + g) * 64 + r;
            ore[o] = fre[0]; ore[o + 32] = fre[1]; oim[o] = fim[0]; oim[o + 32] = fim[1];
        }
    }
}


DI void s5_pair_long(const Params& p, int j, LAS unsigned char* lds) {
    const int tid = opaque_tid(), lane = tid & 63, wave = __builtin_amdgcn_readfirstlane(tid >> 6), r = lane & 31, hh = lane >> 5, c16 = lane & 15, q16 = lane >> 4;
    const int s = wave & 1, pairi = wave >> 1;
    const int task = opaque_bid() * 4 + pairi;
    LAS unsigned char* img0 = lds + pairi * (2 * 8704);
    const bf16_t* U = (const bf16_t*)(p.ws + WS_U); bf16_t* GY = (bf16_t*)(p.ws + WS_GY);
    const float* ABall = (const float*)(p.ws + WS_S5AB); const bf16_t* BBall = (const bf16_t*)(p.ws + WS_S5BB); const bf16_t* CCall = (const bf16_t*)(p.ws + WS_S5CC);
    const int tau = 16 * ((r >> 2) & 1) + 4 * (r >> 3) + (r & 3);
    const int seq = task >> 6, g = task & 63, row0 = NSAMP + seq * LP, jg = j * 64 + g;
    bf16x8 bfr[2];
#pragma unroll
    for (int ri = 0; ri < 2; ++ri) bfr[ri] = *(const bf16x8*)(BBall + ((size_t)(jg * 2 + ri) * 64 + 32 * s + r) * 16 + 8 * hh);
    const float ar = ABall[(jg * 64 + 32 * s + r) * 2], ai = ABall[(jg * 64 + 32 * s + r) * 2 + 1];
    float cr = 0.f, ci = 0.f, fre = 0.f, fim = 0.f;
    bf16x8 cfr[4];
#pragma unroll
    for (int ks = 0; ks < 4; ++ks) cfr[ks] = *(const bf16x8*)(CCall + (size_t)(jg * 16 + c16) * 128 + 32 * ks + 8 * q16);
    const float dsk = p.in[I_S5D][j * 1024 + 16 * g + c16];
    constexpr int nch = (LP + 31) >> 5;
    const bf16_t* ufp = U + (size_t)(row0 + tau) * D + 16 * g + 8 * hh;
    const bf16_t* usp = U + (size_t)(row0 + 16 * s + 4 * q16) * D + 16 * g + c16;
    bf16x8 uf_n = *(const bf16x8*)ufp; bf16_t us_n[4];
#pragma unroll
    for (int e = 0; e < 4; ++e) us_n[e] = usp[(size_t)e * D];
#pragma unroll 1
    for (int c = 0; c < nch; ++c) {
        const int t0 = 32 * c;
        LAS unsigned char* img = img0 + (c & 1) * 8704;
        const bf16x8 uf = uf_n; bf16_t us[4];
#pragma unroll
        for (int e = 0; e < 4; ++e) us[e] = us_n[e];
        if (c + 1 < nch) {
            uf_n = *(const bf16x8*)(ufp + (size_t)(t0 + 32) * D);
#pragma unroll
            for (int e = 0; e < 4; ++e) us_n[e] = usp[(size_t)(t0 + 32 + e) * D];
        }
        f32x16 X[2];
#pragma unroll
        for (int ri = 0; ri < 2; ++ri) { f32x16 z;
#pragma unroll
            for (int i = 0; i < 16; ++i) z[i] = 0.f;
            X[ri] = __builtin_amdgcn_mfma_f32_32x32x16_bf16(uf, bfr[ri], z, 0, 0, 0); }
        {
            float sr = hh ? 0.f : cr, si = hh ? 0.f : ci;
#pragma unroll
            for (int i = 0; i < 16; ++i) {
                float nr = fmaf(ar, sr, X[0][i]); nr = fmaf(-ai, si, nr);
                float ni = fmaf(ar, si, X[1][i]); ni = fmaf(ai, sr, ni);
                sr = nr; si = ni; X[0][i] = sr; X[1][i] = si;
            }
            if (c == nch - 1) { fre = X[0][15]; fim = X[1][15]; }
            const auto sw0 = __builtin_amdgcn_permlane32_swap(__float_as_uint(X[0][15]), __float_as_uint(X[0][15]), false, false);
            const auto sw1 = __builtin_amdgcn_permlane32_swap(__float_as_uint(X[1][15]), __float_as_uint(X[1][15]), false, false);
            const float er = __uint_as_float(sw0[0]), ei = __uint_as_float(sw1[0]);
            float xr = hh ? er : 0.f, xi = hh ? ei : 0.f;
#pragma unroll
            for (int i = 0; i < 16; ++i) {
                const float tr = ar * xr - ai * xi, ti = ar * xi + ai * xr; xr = tr; xi = ti;
                X[0][i] += xr; X[1][i] += xi;
            }
            { const auto cw0 = __builtin_amdgcn_permlane32_swap(__float_as_uint(X[0][15]), __float_as_uint(X[0][15]), false, false);
              const auto cw1 = __builtin_amdgcn_permlane32_swap(__float_as_uint(X[1][15]), __float_as_uint(X[1][15]), false, false);
              cr = __uint_as_float(cw0[1]); ci = __uint_as_float(cw1[1]); }
#pragma unroll
            for (int i = 0; i < 16; ++i) *(LAS unsigned*)(img + (16 * hh + i) * 272 + 4 * (32 * s + r)) = cvt_pk_bf16(X[0][i], X[1][i]);
        }
        asm volatile("s_waitcnt lgkmcnt(0)" ::: "memory");
        __syncthreads();
        f32x4 Dm = (f32x4){0.f, 0.f, 0.f, 0.f};
#pragma unroll
        for (int ks = 0; ks < 4; ++ks) { const bf16x8 a = *(const LAS bf16x8*)(img + (16 * s + c16) * 272 + (32 * ks + 8 * q16) * 2);
            Dm = __builtin_amdgcn_mfma_f32_16x16x32_bf16(a, cfr[ks], Dm, 0, 0, 0); }
#pragma unroll
        for (int rg = 0; rg < 4; ++rg) { const int t = t0 + 16 * s + 4 * q16 + rg;
            if (t < LP) { const size_t off = (size_t)(row0 + t) * D + 16 * g + c16; const float y = Dm[rg] + dsk * bf2f(us[rg]); GY[off] = (bf16_t)(cvt_pk_bf16(gelu_f(y), 0.f) & 0xffffu); } }
    }
    if (hh == 0) {
        const size_t o = ((size_t)(j * 8 + seq) * 64 + g) * 64 + 32 * s + r;
        p.out[O_S5RP + o] = fre; p.out[O_S5IP + o] = fim;
    }
}

DI void rg_scan_a(const Params& p) {
    const int tid = opaque_tid(); const int lane = tid & 63, gw = opaque_bid() * 8 + (tid >> 6), NGW = (int)gridDim.x * 8;
    const unsigned* AB = (const unsigned*)(p.ws + WS_AB); float* RS = (float*)(p.ws + WS_RSUM);
    for (int task = gw; task < 274 * 16; task += NGW) {
        const int chunk = task >> 4, ch = 64 * (task & 15) + lane;
        unsigned w[64];
#pragma unroll
        for (int i = 0; i < 64; ++i) w[i] = AB[(size_t)(64 * chunk + i) * D + ch];
        float A = 1.f, B = 0.f;
#pragma unroll
        for (int i = 0; i < 64; ++i) { const float a = __builtin_amdgcn_exp2f(half_lo(w[i])); B = fmaf(a, B, half_hi(w[i])); A *= a; }
        *(float2*)(RS + ((size_t)chunk * D + ch) * 2) = make_float2(A, B);
    }
}
DI void rg_scan_b(const Params& p, int j) {
    const int tid = opaque_tid(); const int lane = tid & 63, gw = opaque_bid() * 8 + (tid >> 6), NGW = (int)gridDim.x * 8;
    const unsigned* AB = (const unsigned*)(p.ws + WS_AB); const float* RS = (const float*)(p.ws + WS_RSUM);
    const bf16_t* GATE = (const bf16_t*)(p.ws + WS_GATE); bf16_t* Y = (bf16_t*)(p.ws + WS_XC);
    for (int task = gw; task < 274 * 16; task += NGW) {
        const int chunk = task >> 4, ch = 64 * (task & 15) + lane;
        float h = 0.f;
        {
            float2 ab[33];
#pragma unroll
            for (int i = 0; i < 33; ++i) { const int k = chunk - 33 + i; ab[i] = (k >= 0) ? *(const float2*)(RS + ((size_t)k * D + ch) * 2) : make_float2(1.f, 0.f); }
#pragma unroll
            for (int i = 0; i < 33; ++i) h = fmaf(ab[i].x, h, ab[i].y);
        }
        asm volatile("" ::: "memory");
#pragma unroll 1
        for (int hf = 0; hf < 2; ++hf) {
            const int rbase = 64 * chunk + 32 * hf;
            unsigned w[32]; bf16_t gt[32];
#pragma unroll
            for (int i = 0; i < 32; ++i) { w[i] = AB[(size_t)(rbase + i) * D + ch]; gt[i] = GATE[(size_t)(rbase + i) * D + ch]; }
#pragma unroll
            for (int i = 0; i < 32; ++i) {
                const int row = rbase + i;
                h = fmaf(__builtin_amdgcn_exp2f(half_lo(w[i])), h, half_hi(w[i]));
                Y[(size_t)row * D + ch] = (bf16_t)(cvt_pk_bf16(h * bf2f(gt[i]), 0.f) & 0xffffu);
                if (row < NSAMP) { if ((row & 7) == 7) p.out[O_RGHS + ((size_t)j * 128 + (row >> 3)) * D + ch] = h; }
                else { const int q = row - NSAMP, b = q / LP, t = q - b * LP; if (t == LP - 1) p.out[O_RGHP + ((size_t)j * 8 + b) * D + ch] = h; }
            }
            asm volatile("" ::: "memory");
        }
    }
}

#define XB_TMO      128
#define XB_XCNT(j)  (256  + 64 * (j))
#define XB_XSUB(j)  (1280 + 64 * (j))
#define XB_XGEN(j)  (2304 + 64 * (j))
#define XB_TOP      3328
#define XB_TOPGEN   3392
#define XCD_BAR_WORDS 3456
#define XB_SPIN_CAP (1u << 20)
DI unsigned xb_ld(unsigned* p)              { return __hip_atomic_load(p, __ATOMIC_RELAXED, __HIP_MEMORY_SCOPE_AGENT); }
DI unsigned xb_add(unsigned* p, unsigned v) { return __hip_atomic_fetch_add(p, v, __ATOMIC_RELAXED, __HIP_MEMORY_SCOPE_AGENT); }
DI unsigned xb_xcc_id() { return (unsigned)__builtin_amdgcn_s_getreg((3 << 11) | 20) & 0xFu; }
#define XB_SPIN(cond, bar) do { unsigned _sp = 0; while (cond) { __builtin_amdgcn_s_sleep(1); \
    if ((++_sp & 255u) == 0u) { if (xb_ld(&(bar)[XB_TMO])) break; if (_sp > XB_SPIN_CAP) { atomicAdd(&(bar)[XB_TMO], 1u); break; } } } } while (0)
struct XcdBarrier { unsigned* bar; unsigned x; volatile LAS unsigned* st; };
DI XcdBarrier xcd_barrier_post(unsigned* bar, volatile LAS unsigned* st) {
    XcdBarrier b; b.bar = bar; b.x = xb_xcc_id(); b.st = st;
    if (threadIdx.x == 0) (void)xb_add(&bar[XB_XCNT(b.x)], 1u);
    return b;
}
DI void xcd_barrier_complete(unsigned* bar, unsigned x, unsigned& nloc, unsigned& nx) {
    const unsigned G = gridDim.x * gridDim.y * gridDim.z;
    unsigned sum, cnt, mine, sp = 0u;
    for (;;) {
        sum = 0u; cnt = 0u; mine = 0u;
#pragma unroll
        for (unsigned j = 0; j < 16; ++j) { const unsigned c = xb_ld(&bar[XB_XCNT(j)]); sum += c; cnt += (c > 0u) ? 1u : 0u; mine = (j == x) ? c : mine; }
        if (sum == G) break;
        __builtin_amdgcn_s_sleep(1);
        if ((++sp & 255u) == 0u) { if (xb_ld(&bar[XB_TMO])) break; if (sp > XB_SPIN_CAP) { atomicAdd(&bar[XB_TMO], 1u); break; } }
    }
    nloc = mine > 0u ? mine : 1u; nx = cnt > 0u ? cnt : 1u;
}
DI void xcd_barrier(const XcdBarrier& b) {
    asm volatile("s_waitcnt vmcnt(0)" ::: "memory");
    __syncthreads();
    if (threadIdx.x == 0) {
        unsigned* bar = b.bar;
        __builtin_amdgcn_s_waitcnt(0);
        unsigned nloc = b.st[0], nx = b.st[1];
        if (nloc == 0u) { xcd_barrier_complete(bar, b.x, nloc, nx); b.st[0] = nloc; b.st[1] = nx; }
        const unsigned old = xb_add(&bar[XB_XSUB(b.x)], 1u);
        const unsigned gen = old / nloc;
        if (old + 1u == (gen + 1u) * nloc) {
            __builtin_amdgcn_fence(__ATOMIC_RELEASE, "agent");
            asm volatile("s_waitcnt vmcnt(0)" ::: "memory");
            const unsigned og = xb_add(&bar[XB_TOP], 1u);
            const unsigned tg = og / nx;
            if (og + 1u == (tg + 1u) * nx) xb_add(&bar[XB_TOPGEN], 1u);
            else XB_SPIN(xb_ld(&bar[XB_TOPGEN]) == tg, bar);
            __builtin_amdgcn_fence(__ATOMIC_ACQUIRE, "agent");
            xb_add(&bar[XB_XGEN(b.x)], 1u);
            asm volatile("s_waitcnt vmcnt(0)" ::: "memory");
        } else {
            XB_SPIN(xb_ld(&bar[XB_XGEN(b.x)]) == gen, bar);
            __builtin_amdgcn_fence(__ATOMIC_ACQUIRE, "agent");
            asm volatile("s_waitcnt vmcnt(0)" ::: "memory");
        }
    }
    __syncthreads();
}

constexpr int LDS_BYTES = pg8::STAGE_BYTES + 4096 + 10240;
__global__ void __launch_bounds__(512, 2) fwd_megakernel(Params p) {
    extern __shared__ __attribute__((aligned(16))) unsigned char lds_raw[];
    LAS unsigned char* lds = (LAS unsigned char*)lds_raw;
    cg::grid_group grid = cg::this_grid();
    unsigned char* ws = p.ws;
    bf16_t* H = (bf16_t*)(ws + WS_H); unsigned short* Z = (unsigned short*)(ws + WS_Z);

    if (threadIdx.x < 4) ((LAS unsigned*)(lds + pg8::STAGE_BYTES + 3072))[threadIdx.x] = 0u;
    __syncthreads();
    const XcdBarrier xbar = xcd_barrier_post((unsigned*)(ws + WS_BAR), (volatile LAS unsigned*)(lds + pg8::STAGE_BYTES + 3072));
    p0_phase(p, lds);
    if (DUP_P0) { GSYNC(); p0_phase(p, lds); }
    grid.sync();
#pragma unroll 1
    for (int i = 0; i < 4; ++i) {
        const int j = i >> 1;
        if ((i & 1) == 0) {
            { pg8::Gemm g{H, (const bf16_t*)(ws + WS_W_S5IN) + (size_t)j * 1024 * 1024};
              EpiStoreBf16 E{(bf16_t*)(ws + WS_U), D}; for (int rep = 0; rep < (DUP_G1 ? 2 : 1); ++rep) { if (rep) GSYNC(); pg8::gemm_phase<EpiStoreBf16, false, pg8::GC<D, 1024, 1024, 69, 4, 256, 0>>(lds, g, E); } }
            GSYNC();
            for (int rep = 0; rep < (DUP_S5 ? 2 : 1); ++rep) {
                if (rep) GSYNC();
                const int wv = __builtin_amdgcn_readfirstlane(threadIdx.x >> 6);
                if (gridDim.x == 256) { if (blockIdx.x < 128) s5_pair_long(p, j, lds); else { s5_phase(p, j, lds, 512, wv * 128 + ((int)blockIdx.x - 128), 1024); if (i == 0) { __syncthreads(); cvt_rest(p, lds, (int)blockIdx.x - 128, 128); } } }
                else s5_phase(p, j, lds, 0, wv * (int)gridDim.x + (int)blockIdx.x, 8 * (int)gridDim.x);
            }
            GSYNC();
            { pg8::Gemm g{(const bf16_t*)(ws + WS_GY), (const bf16_t*)(ws + WS_W_S5OUT) + (size_t)j * 2048 * 1024};
              EpiGluRes E{Z, H, (bf16_t*)(ws + WS_PART_RG)}; pg8::gemm_phase<EpiGluRes, false, pg8::GC<D, 1024, 1024, 69, 8, 256, 0>, 4>(lds, g, E); }
            GSYNC();
        } else {
            { pg8::Gemm g{H, (const bf16_t*)(ws + WS_W_RGIN) + (size_t)j * 2048 * 1024};
              EpiRgIn E{j};
              for (int rep = 0; rep < (DUP_RG ? 2 : 1); ++rep) { if (rep) GSYNC(); pg8::gemm_phase<EpiRgIn, true, pg8::GC<D, 1024, 1024, 70, 8, 253, 0>>(lds, g, E); } }
            GSYNC();
            { pg8::Gemm g{(const bf16_t*)(ws + WS_XC), (const bf16_t*)(ws + WS_W_RGG) + (size_t)j * 2048 * 256};
              EpiRgGates E{(const bf16_t*)(ws + WS_XC), (unsigned*)(ws + WS_AB), p.in[I_RGBG] + (size_t)j * 2048, (const float*)(ws + WS_RGSP) + (size_t)j * 1024, p.in[I_RGH] + (size_t)j * 128 * D};
              for (int rep = 0; rep < (DUP_RG ? 2 : 1); ++rep) { if (rep) GSYNC(); pg8::gemm_phase<EpiRgGates, false, pg8::GC<D, 256, 256, 69, 8, 256, 1>>(lds, g, E); } }
            GSYNC();
            rg_scan_a(p);
            if (DUP_SCAN) { GSYNC(); rg_scan_a(p); }
            GSYNC();
            rg_scan_b(p, j);
            if (DUP_SCAN) { GSYNC(); rg_scan_b(p, j); }
            GSYNC();
            { pg8::Gemm g{(const bf16_t*)(ws + WS_XC), (const bf16_t*)(ws + WS_W_RGOUT) + (size_t)j * 1024 * 1024};
              EpiAddZ E{Z, (bf16_t*)(ws + WS_PART_RG), H}; pg8::gemm_phase<EpiAddZ, false, pg8::GC<D, 1024, 1024, 69, 4, 256, 0>, 4>(lds, g, E); }
            GSYNC();
        }
        ln_phase(p, 2 * i, false, false, 4, (const bf16_t*)(ws + WS_PART_RG), (i & 1) == 0);
        GSYNC();
        { pg8::Gemm g{H, (const bf16_t*)(ws + WS_W_UP) + (size_t)i * FF2 * 1024};
          EpiFfnUp E{i};
          for (int rep = 0; rep < (DUP_UP ? 2 : 1); ++rep) { if (rep) GSYNC(); pg8::gemm_phase<EpiFfnUp, true, pg8::GC<D, 1024, 1024, 69, 22, 254, 0>>(lds, g, E); } }
        GSYNC();
        { pg8::Gemm g{(const bf16_t*)(ws + WS_ACT), (const bf16_t*)(ws + WS_W_DN) + (size_t)i * 1024 * FF};
          EpiAddZ E{Z, (bf16_t*)(ws + WS_PART_FFN), H}; pg8::gemm_phase<EpiAddZ, false, pg8::GC<FF, FF, FF, 69, 4, 256, 0>, 11>(lds, g, E); }
        GSYNC();
        ln_phase(p, 2 * i + 1, i == 3, false, 11, (const bf16_t*)(ws + WS_PART_FFN), false);
        if (i < 3) GSYNC();
    }
}

extern "C" void kernel_launch(void* const* d_in, const int* in_sizes, int n_in, void* d_out, int out_size, void* d_ws, size_t ws_size, hipStream_t stream) {
    static int grid_blocks = 0;
    if (grid_blocks == 0) {
        if (n_in != 31 || ws_size < WS_END) { fprintf(stderr, "kernel_launch: unexpected inputs (n_in %d, ws %zu, need %zu)\n", n_in, ws_size, (size_t)WS_END); grid_blocks = -1; return; }
        int dev = 0, cus = 0, per_cu = 0;
        hipGetDevice(&dev);
        hipDeviceGetAttribute(&cus, hipDeviceAttributeMultiprocessorCount, dev);
        hipFuncSetAttribute((const void*)fwd_megakernel, hipFuncAttributeMaxDynamicSharedMemorySize, LDS_BYTES);
        hipOccupancyMaxActiveBlocksPerMultiprocessor(&per_cu, (const void*)fwd_megakernel, 512, LDS_BYTES);
        if (per_cu < 1) per_cu = 1;
        grid_blocks = cus * 1;
        (void)hipGetLastError();
    }
    if (grid_blocks < 0) return;
    Params p{};
    for (int i = 0; i < 31; ++i) p.in[i] = (const float*)d_in[i];
    p.out = (float*)d_out; p.ws = (unsigned char*)d_ws;
    (void)hipMemsetAsync((char*)d_ws + WS_BAR, 0, 16384, stream);
    void* args[] = {&p};
    hipError_t e = hipLaunchCooperativeKernel((const void*)fwd_megakernel, dim3(grid_blocks), dim3(512), args, LDS_BYTES, stream);
    if (e != hipSuccess) fprintf(stderr, "cooperative launch failed: %s (grid %d)\n", hipGetErrorString(e), grid_blocks);
}
```
